# Optimizing an MI355X kernel written in HIP

```python
import math
import jax, jax.numpy as jnp
from jax import lax
import numpy as np

D_MODEL = 2048
BATCH = 2
SEQ = 4096
DEPTH = 2
DEC_BATCH = 8
DEC_SEQ = 1
PAST_LEN = 16384
PAGE_SIZE = 128

N_A_LAYERS = DEPTH // 2
N_B_LAYERS = DEPTH - N_A_LAYERS
EPS = 1e-6

SSM_EXPAND = 2
D_INNER = SSM_EXPAND * D_MODEL
SSM_HEAD_DIM = 64
SSM_HEADS = D_INNER // SSM_HEAD_DIM
SSM_GROUPS = 8
HEADS_PER_GROUP = SSM_HEADS // SSM_GROUPS
SSM_STATE = 128
CONV_W = 4
CONV_DIM = D_INNER + 2 * SSM_GROUPS * SSM_STATE
IN_PROJ_DIM = D_INNER + CONV_DIM + SSM_HEADS
SSD_CHUNK = 128

HEAD_DIM = 128
KV_HEADS = 8
DIL_WINDOWS = (128, 512, 2048)
DIL_RATES = (1, 4, 16)
N_DIL = len(DIL_RATES)
Q_HEADS = N_DIL * KV_HEADS
N_SLOTS = DIL_WINDOWS[0] // DIL_RATES[0] + 1
W_MAX = max(DIL_WINDOWS)
ATT_BLOCK = 128
ROPE_THETA = 10000.0

FFN_HIDDEN = -(-8 * D_MODEL // (3 * 256)) * 256

kernel_name = "yoco_mamba2_dilated_swa_step"


def rmsnorm(x, g):
    xf = x.astype(jnp.float32)
    y = xf * lax.rsqrt(jnp.mean(xf * xf, axis=-1, keepdims=True) + EPS)
    return (y * g.astype(jnp.float32)).astype(x.dtype)


def rope(x, pos):
    half = HEAD_DIM // 2
    inv = jnp.power(jnp.float32(ROPE_THETA), -jnp.arange(half, dtype=jnp.float32) / half)
    ang = pos.astype(jnp.float32)[:, None] * inv[None, :]
    cos = jnp.cos(ang)[None, :, None, :]
    sin = jnp.sin(ang)[None, :, None, :]
    xf = x.astype(jnp.float32)
    x1, x2 = xf[..., :half], xf[..., half:]
    return jnp.concatenate([x1 * cos - x2 * sin, x2 * cos + x1 * sin], axis=-1).astype(x.dtype)


def swiglu(h, w_gu, w_down):
    g, u = jnp.split(h @ w_gu, 2, axis=-1)
    return (jax.nn.silu(g) * u) @ w_down


def causal_dwconv(xe, w, b):
    L = xe.shape[1] - (CONV_W - 1)
    acc = b
    for k in range(CONV_W):
        acc = acc + xe[:, k:k + L] * w[k]
    return jax.nn.silu(acc)


def ssd_chunked(xdt, dA, Bm, Cm, h0):
    b, L = xdt.shape[:2]
    Q = SSD_CHUNK if L % SSD_CHUNK == 0 else L
    nc = L // Q
    X = xdt.reshape(b, nc, Q, SSM_GROUPS, HEADS_PER_GROUP, SSM_HEAD_DIM)
    A = dA.reshape(b, nc, Q, SSM_GROUPS, HEADS_PER_GROUP)
    Bc = Bm.reshape(b, nc, Q, SSM_GROUPS, SSM_STATE)
    Cc = Cm.reshape(b, nc, Q, SSM_GROUPS, SSM_STATE)
    A_cs = jnp.cumsum(A, axis=2)
    seg = A_cs[:, :, :, None] - A_cs[:, :, None, :]
    mask = jnp.tril(jnp.ones((Q, Q), dtype=bool))[None, None, :, :, None, None]
    decay = jnp.exp(jnp.where(mask, seg, -jnp.inf))
    CB = jnp.einsum('bclgn,bcsgn->bclsg', Cc, Bc)
    att = CB[..., None] * decay
    y_diag = jnp.einsum('bclsgr,bcsgrp->bclgrp', att, X)
    decay_end = jnp.exp(A_cs[:, :, -1:] - A_cs)
    chunk_states = jnp.einsum('bclgn,bclgrp->bcgrpn', Bc, X * decay_end[..., None])
    chunk_decay = jnp.exp(A_cs[:, :, -1])

    def step(h, inp):
        s_c, d_c = inp
        return h * d_c[..., None, None] + s_c, h

    h_final, h_prev = lax.scan(step, h0, (jnp.moveaxis(chunk_states, 1, 0), jnp.moveaxis(chunk_decay, 1, 0)))
    h_prev = jnp.moveaxis(h_prev, 0, 1)
    y_off = jnp.einsum('bclgn,bcgrpn->bclgrp', Cc, h_prev) * jnp.exp(A_cs)[..., None]
    y = (y_diag + y_off).reshape(b, L, SSM_GROUPS, HEADS_PER_GROUP, SSM_HEAD_DIM)
    return y, h_final


def ssd_recurrent(xdt, dA, Bm, Cm, h0):
    def step(h, inp):
        x_t, a_t, b_t, c_t = inp
        h = h * jnp.exp(a_t)[..., None, None] + x_t[..., None] * b_t[:, :, None, None, :]
        return h, jnp.einsum('bgrpn,bgn->bgrp', h, c_t)

    mv = lambda a: jnp.moveaxis(a, 1, 0)
    h, ys = lax.scan(step, h0, (mv(xdt), mv(dA), mv(Bm), mv(Cm)))
    return jnp.moveaxis(ys, 0, 1), h


def mamba2_mixer(h, conv_prev, ssm_prev, chunked, w_in, conv_w, conv_b, dt_bias, a_log, d_skip, gate_norm, w_out):
    b, L, _ = h.shape
    zxbcdt = h @ w_in
    z = zxbcdt[..., :D_INNER]
    xbc = zxbcdt[..., D_INNER:D_INNER + CONV_DIM]
    dt = zxbcdt[..., D_INNER + CONV_DIM:]
    xe = jnp.concatenate([conv_prev.astype(xbc.dtype), xbc], axis=1)
    new_conv = xe[:, -(CONV_W - 1):]
    xbc = causal_dwconv(xe, conv_w, conv_b).astype(jnp.float32)
    xs = xbc[..., :D_INNER].reshape(b, L, SSM_GROUPS, HEADS_PER_GROUP, SSM_HEAD_DIM)
    Bm = xbc[..., D_INNER:D_INNER + SSM_GROUPS * SSM_STATE].reshape(b, L, SSM_GROUPS, SSM_STATE)
    Cm = xbc[..., D_INNER + SSM_GROUPS * SSM_STATE:].reshape(b, L, SSM_GROUPS, SSM_STATE)
    dt = jax.nn.softplus(dt.astype(jnp.float32) + dt_bias.astype(jnp.float32))
    dt = dt.reshape(b, L, SSM_GROUPS, HEADS_PER_GROUP)
    A = -jnp.exp(a_log.astype(jnp.float32)).reshape(SSM_GROUPS, HEADS_PER_GROUP)
    dA = dt * A
    xdt = xs * dt[..., None]
    h0 = ssm_prev.astype(jnp.float32).reshape(b, SSM_GROUPS, HEADS_PER_GROUP, SSM_HEAD_DIM, SSM_STATE)
    if chunked:
        y, h_new = ssd_chunked(xdt, dA, Bm, Cm, h0)
    else:
        y, h_new = ssd_recurrent(xdt, dA, Bm, Cm, h0)
    y = y + xs * d_skip.astype(jnp.float32).reshape(SSM_GROUPS, HEADS_PER_GROUP)[..., None]
    y = y.reshape(b, L, D_INNER) * jax.nn.silu(z.astype(jnp.float32))
    yg = y.reshape(b, L, SSM_GROUPS, D_INNER // SSM_GROUPS)
    yg = yg * lax.rsqrt(jnp.mean(yg * yg, axis=-1, keepdims=True) + EPS)
    y = (yg.reshape(b, L, D_INNER) * gate_norm.astype(jnp.float32)).astype(h.dtype)
    out = y @ w_out
    return out, new_conv, h_new.reshape(b, SSM_HEADS, SSM_HEAD_DIM, SSM_STATE)


def dilated_attention(q, k_all, v_all, q_row0):
    b, Lq = q.shape[:2]
    QB = ATT_BLOCK if Lq % ATT_BLOCK == 0 else Lq
    nb = Lq // QB
    offs = jnp.arange(N_SLOTS, dtype=jnp.int32)[None, :] * jnp.array(DIL_RATES, dtype=jnp.int32)[:, None]
    scale = HEAD_DIM ** -0.5

    def block(i):
        q_blk = lax.dynamic_slice_in_dim(q, i * QB, QB, axis=1)
        rows = q_row0 + i * QB + jnp.arange(QB, dtype=jnp.int32)
        idx = rows[None, :, None] - offs[:, None, :]
        valid = idx >= 0
        idx = jnp.maximum(idx, 0)
        k_g = jnp.take(k_all, idx, axis=1)
        v_g = jnp.take(v_all, idx, axis=1)
        s = jnp.einsum('bqghd,bgqjhd->bghqj', q_blk, k_g).astype(jnp.float32) * scale
        s = jnp.where(valid[None, :, None], s, -jnp.inf)
        lse = jax.nn.logsumexp(s, axis=-1)
        p = jnp.exp(s - lse[..., None])
        o = jnp.einsum('bghqj,bgqjhd->bqghd', p, v_g.astype(jnp.float32))
        w = jax.nn.softmax(lse, axis=1)
        out = jnp.einsum('bghq,bqghd->bqhd', w, o)
        return out.astype(q.dtype)

    out = lax.map(block, jnp.arange(nb, dtype=jnp.int32))
    return jnp.transpose(out, (1, 0, 2, 3, 4)).reshape(b, Lq, KV_HEADS, HEAD_DIM)


def run_trunk(x, pos, conv_state, ssm_state, k_past, v_past, chunked,
              a_norm, a_w_in, a_conv_w, a_conv_b, a_dt_bias, a_log, a_d, a_gate_norm, a_w_out,
              kv_norm, w_kv, b_norm, b_w_q, b_w_o, ffn_norm, ffn_w_gu, ffn_w_down, final_norm):
    b, L, _ = x.shape
    convs, ssms = [], []
    k_new = v_new = k_all = v_all = None
    for l in range(DEPTH):
        if l < N_A_LAYERS:
            o, c, s = mamba2_mixer(rmsnorm(x, a_norm[l]), conv_state[l], ssm_state[l], chunked,
                                   a_w_in[l], a_conv_w[l], a_conv_b[l], a_dt_bias[l], a_log[l],
                                   a_d[l], a_gate_norm[l], a_w_out[l])
            x = x + o
            convs.append(c)
            ssms.append(s)
        else:
            j = l - N_A_LAYERS
            if j == 0:
                kv = rmsnorm(x, kv_norm) @ w_kv
                k_new = rope(kv[..., :KV_HEADS * HEAD_DIM].reshape(b, L, KV_HEADS, HEAD_DIM), pos)
                v_new = kv[..., KV_HEADS * HEAD_DIM:].reshape(b, L, KV_HEADS, HEAD_DIM)
                k_all = jnp.concatenate([k_past.astype(k_new.dtype), k_new], axis=1)
                v_all = jnp.concatenate([v_past.astype(v_new.dtype), v_new], axis=1)
            q = (rmsnorm(x, b_norm[j]) @ b_w_q[j]).reshape(b, L, Q_HEADS, HEAD_DIM)
            q = rope(q, pos).reshape(b, L, N_DIL, KV_HEADS, HEAD_DIM)
            o = dilated_attention(q, k_all, v_all, k_past.shape[1])
            x = x + o.reshape(b, L, KV_HEADS * HEAD_DIM) @ b_w_o[j]
        x = x + swiglu(rmsnorm(x, ffn_norm[l]), ffn_w_gu[l], ffn_w_down[l])
    return rmsnorm(x, final_norm), jnp.stack(convs), jnp.stack(ssms), k_new, v_new


def setup_inputs(seed: int = 0) -> dict:
    key = jax.random.key(seed)
    ks = iter(jax.random.split(key, 40))
    nrm = lambda shape, scale: jax.random.normal(next(ks), shape, jnp.float32) * scale
    kv_buf = min(W_MAX, PAST_LEN)
    dt0 = jnp.exp(jax.random.uniform(next(ks), (N_A_LAYERS, SSM_HEADS), jnp.float32,
                                     minval=math.log(1e-3), maxval=math.log(1e-1)))
    return {
        "x_prompt": nrm((BATCH, SEQ, D_MODEL), 1.0),
        "x_sample": nrm((DEC_BATCH, DEC_SEQ, D_MODEL), 1.0),
        "state_conv": nrm((N_A_LAYERS, DEC_BATCH, CONV_W - 1, CONV_DIM), 1.0),
        "state_ssm": nrm((N_A_LAYERS, DEC_BATCH, SSM_HEADS, SSM_HEAD_DIM, SSM_STATE), 0.1),
        "cache_k": nrm((DEC_BATCH, kv_buf, KV_HEADS, HEAD_DIM), 1.0),
        "cache_v": nrm((DEC_BATCH, kv_buf, KV_HEADS, HEAD_DIM), 1.0),
        "a_norm": 1.0 + nrm((N_A_LAYERS, D_MODEL), 0.01),
        "a_w_in": nrm((N_A_LAYERS, D_MODEL, IN_PROJ_DIM), D_MODEL ** -0.5),
        "a_conv_w": nrm((N_A_LAYERS, CONV_W, CONV_DIM), CONV_W ** -0.5),
        "a_conv_b": nrm((N_A_LAYERS, CONV_DIM), 0.01),
        "a_dt_bias": dt0 + jnp.log(-jnp.expm1(-dt0)),
        "a_log": jnp.log(jax.random.uniform(next(ks), (N_A_LAYERS, SSM_HEADS), jnp.float32, minval=1.0, maxval=16.0)),
        "a_d": 1.0 + nrm((N_A_LAYERS, SSM_HEADS), 0.01),
        "a_gate_norm": 1.0 + nrm((N_A_LAYERS, D_INNER), 0.01),
        "a_w_out": nrm((N_A_LAYERS, D_INNER, D_MODEL), D_INNER ** -0.5),
        "kv_norm": 1.0 + nrm((D_MODEL,), 0.01),
        "w_kv": nrm((D_MODEL, 2 * KV_HEADS * HEAD_DIM), D_MODEL ** -0.5),
        "b_norm": 1.0 + nrm((N_B_LAYERS, D_MODEL), 0.01),
        "b_w_q": nrm((N_B_LAYERS, D_MODEL, Q_HEADS * HEAD_DIM), D_MODEL ** -0.5),
        "b_w_o": nrm((N_B_LAYERS, KV_HEADS * HEAD_DIM, D_MODEL), (KV_HEADS * HEAD_DIM) ** -0.5),
        "ffn_norm": 1.0 + nrm((DEPTH, D_MODEL), 0.01),
        "ffn_w_gu": nrm((DEPTH, D_MODEL, 2 * FFN_HIDDEN), D_MODEL ** -0.5),
        "ffn_w_down": nrm((DEPTH, FFN_HIDDEN, D_MODEL), FFN_HIDDEN ** -0.5),
        "final_norm": 1.0 + nrm((D_MODEL,), 0.01),
    }


def reference(x_prompt, x_sample, state_conv, state_ssm, cache_k, cache_v,
              a_norm, a_w_in, a_conv_w, a_conv_b, a_dt_bias, a_log, a_d, a_gate_norm, a_w_out,
              kv_norm, w_kv, b_norm, b_w_q, b_w_o, ffn_norm, ffn_w_gu, ffn_w_down, final_norm):
    weights = (a_norm, a_w_in, a_conv_w, a_conv_b, a_dt_bias, a_log, a_d, a_gate_norm, a_w_out,
               kv_norm, w_kv, b_norm, b_w_q, b_w_o, ffn_norm, ffn_w_gu, ffn_w_down, final_norm)
    bp, Lp, _ = x_prompt.shape
    pos_p = jnp.arange(Lp, dtype=jnp.int32)
    zc = jnp.zeros((N_A_LAYERS, bp, CONV_W - 1, CONV_DIM), x_prompt.dtype)
    zs = jnp.zeros((N_A_LAYERS, bp, SSM_HEADS, SSM_HEAD_DIM, SSM_STATE), jnp.float32)
    zk = jnp.zeros((bp, 0, KV_HEADS, HEAD_DIM), x_prompt.dtype)
    y_prompt, p_conv, p_ssm, p_k, p_v = run_trunk(x_prompt, pos_p, zc, zs, zk, zk, True, *weights)
    keep = min(W_MAX, Lp)
    p_k = p_k[:, Lp - keep:]
    p_v = p_v[:, Lp - keep:]
    Ls = x_sample.shape[1]
    pos_s = PAST_LEN + jnp.arange(Ls, dtype=jnp.int32)
    y_sample, s_conv, s_ssm, s_k, s_v = run_trunk(x_sample, pos_s, state_conv, state_ssm, cache_k, cache_v, False, *weights)
    return (y_prompt, y_sample, p_conv, p_ssm, p_k, p_v, s_conv, s_ssm, s_k, s_v)
```

```cpp
#include <hip/hip_runtime.h>
#include <hip/hip_cooperative_groups.h>
#include <cstdio>
namespace cg = cooperative_groups;

#define LAS __attribute__((address_space(3)))
typedef unsigned short bf16_t;
typedef short bf16x8 __attribute__((ext_vector_type(8)));
typedef float f32x4 __attribute__((ext_vector_type(4)));
typedef float f32x2 __attribute__((ext_vector_type(2)));
typedef unsigned u32x4 __attribute__((ext_vector_type(4)));
typedef unsigned u32x2 __attribute__((ext_vector_type(2)));

constexpr int DM = 2048, SEQ = 4096, MP = 8192, NS = 8, MV = 8200, MPAD = 8448;
constexpr int DIN = 4096, CONVD = 6144, INP_PAD = 10496, ZLD = 10496;
constexpr int FF = 5632;
constexpr float EPS = 1e-6f;
constexpr int NTHR = 512;
constexpr int LDS_BYTES = 131072 + 16;

constexpr size_t O_YP = 0, O_PCONV = 16793600, O_PSSM = 16830464, O_PK = 17879040, O_PV = 22073344,
                 O_SCONV = 26267648, O_SSSM = 26415104, O_SK = 30609408, O_SV = 30617600;

constexpr size_t al256(size_t x) { return (x + 255) & ~(size_t)255; }
constexpr size_t W_IN = 0;
constexpr size_t W_OUT = W_IN + (size_t)INP_PAD * 2048 * 2;
constexpr size_t W_GU0 = W_OUT + (size_t)2048 * 4096 * 2;
constexpr size_t W_DN0 = W_GU0 + (size_t)11264 * 2048 * 2;
constexpr size_t W_KVQ = W_DN0 + (size_t)2048 * 5632 * 2;
constexpr size_t W_O = W_KVQ + (size_t)5120 * 2048 * 2;
constexpr size_t W_GU1 = W_O + (size_t)2048 * 1024 * 2;
constexpr size_t W_DN1 = W_GU1 + (size_t)11264 * 2048 * 2;
constexpr size_t T_COS = W_DN1 + (size_t)2048 * 5632 * 2;
constexpr size_t T_SIN = T_COS + al256((size_t)4097 * 64 * 4);
constexpr size_t B_XR = T_SIN + al256((size_t)4097 * 64 * 4);
constexpr size_t B_XN = B_XR + (size_t)MPAD * 2048 * 4;
constexpr size_t B_DT = B_XN + (size_t)MPAD * 2048 * 2;
constexpr size_t B_CD = B_DT + (size_t)MPAD * 64 * 4;
constexpr size_t B_GS = B_CD + al256((size_t)2 * 32 * 64 * 4);
constexpr size_t B_BAR = B_GS + al256((size_t)MPAD * 8 * 4);
constexpr size_t B_R = B_BAR + al256((size_t)3456 * 4);
constexpr size_t B_ZX = B_R;
constexpr size_t B_ST = B_ZX + (size_t)MPAD * ZLD * 2;
constexpr size_t B_HPV = B_ST + (size_t)2 * 32 * 64 * 64 * 128 * 2;
constexpr size_t R_END1 = B_HPV + (size_t)2 * 32 * 64 * 64 * 128 * 2;
constexpr size_t B_H = B_R;
constexpr size_t B_KB = B_H + (size_t)MPAD * FF * 2;
constexpr size_t B_VB = B_KB + (size_t)MPAD * 1024 * 2;
constexpr size_t B_QB = B_VB + (size_t)MPAD * 1024 * 2;
constexpr size_t B_OP = B_QB + (size_t)MPAD * 3072 * 2;
constexpr size_t B_LSE = B_OP + (size_t)3 * MP * 1024 * 2;
constexpr size_t B_ATT = B_LSE + al256((size_t)3 * MP * 8 * 4);
constexpr size_t R_END2 = B_ATT + (size_t)MPAD * 1024 * 2;
constexpr size_t WS_NEED = R_END1 > R_END2 ? R_END1 : R_END2;

struct Params {
    const float* in[24];
    float* out;
    unsigned char* ws;
};
typedef const __attribute__((address_space(4))) Params CParams;
__device__ __forceinline__ float __attribute__((ext_vector_type(4))) zero4() { float z = 0.f; asm volatile("" : "+v"(z)); float __attribute__((ext_vector_type(4))) r = {z, z, z, z}; return r; }
__device__ __forceinline__ int get_bid() { int b = blockIdx.x; asm volatile("" : "+s"(b)); return b; }
__device__ __forceinline__ int get_tid() { int t = threadIdx.x; asm volatile("" : "+v"(t)); return t; }

__device__ __forceinline__ float bf2f(unsigned v) { return __uint_as_float(v << 16); }
typedef __bf16 bf16x2_t __attribute__((ext_vector_type(2)));
__device__ __forceinline__ unsigned pk2(float lo, float hi) { f32x2 v = {lo, hi}; bf16x2_t b = __builtin_convertvector(v, bf16x2_t); return __builtin_bit_cast(unsigned, b); }
__device__ __forceinline__ bf16_t f2bf(float v) { return (bf16_t)(pk2(v, 0.f) & 0xffffu); }
__device__ __forceinline__ float silu_f(float v) { return v * __builtin_amdgcn_rcpf(1.f + __expf(-v)); }
__device__ __forceinline__ float softplus_f(float x) { return x > 20.f ? x : log1pf(__expf(x)); }
__device__ __forceinline__ float shl(float v, int src) { return __int_as_float(__builtin_amdgcn_ds_bpermute(src << 2, __float_as_int(v))); }
#define SHX(v, o) shl((v), lane ^ (o))
__device__ __forceinline__ float wave_sum(float v, int lane) { for (int o = 32; o >= 1; o >>= 1) v += SHX(v, o); return v; }
__device__ __forceinline__ float wave_max(float v, int lane) { for (int o = 32; o >= 1; o >>= 1) v = fmaxf(v, SHX(v, o)); return v; }
__device__ __forceinline__ bf16x8 frag_ld(const bf16_t* base, int ld, int row0, int k0, int lane) {
    return *(const bf16x8*)(base + (row0 + (lane & 15)) * ld + k0 + (lane >> 4) * 8);
}


#define XB_TMO      128
#define XB_XCNT(j)  (256  + 64 * (j))
#define XB_XSUB(j)  (1280 + 64 * (j))
#define XB_XGEN(j)  (2304 + 64 * (j))
#define XB_TOP      3328
#define XB_TOPGEN   3392
#define XCD_BAR_WORDS 3456
#define XB_SPIN_CAP (1u << 18)
__device__ __forceinline__ unsigned xb_ld(unsigned* p)              { return __hip_atomic_load(p, __ATOMIC_RELAXED, __HIP_MEMORY_SCOPE_AGENT); }
__device__ __forceinline__ unsigned xb_add(unsigned* p, unsigned v) { return __hip_atomic_fetch_add(p, v, __ATOMIC_RELAXED, __HIP_MEMORY_SCOPE_AGENT); }
__device__ __forceinline__ unsigned xb_xcc_id() { return (unsigned)__builtin_amdgcn_s_getreg((3 << 11) | 20) & 0xFu; }
#define XB_SPIN(cond, bar) do { unsigned _sp = 0; while (cond) { __builtin_amdgcn_s_sleep(1); \
    if ((++_sp & 255u) == 0u) { if (xb_ld(&(bar)[XB_TMO])) break; if (_sp > XB_SPIN_CAP) { atomicAdd(&(bar)[XB_TMO], 1u); break; } } } } while (0)
struct XcdBarrier { unsigned* bar; unsigned x; volatile LAS unsigned* st; };
__device__ __forceinline__ XcdBarrier xcd_barrier_post(unsigned* bar, volatile LAS unsigned* st) {
    XcdBarrier b; b.bar = bar; b.x = xb_xcc_id(); b.st = st;
    if (threadIdx.x == 0) (void)xb_add(&bar[XB_XCNT(b.x)], 1u);
    return b;
}
__device__ __forceinline__ void xcd_barrier_complete(unsigned* bar, unsigned x, unsigned& nloc, unsigned& nx) {
    const unsigned G = gridDim.x * gridDim.y * gridDim.z;
    unsigned sum, cnt, mine, sp = 0u;
    for (;;) {
        sum = 0u; cnt = 0u; mine = 0u;
#pragma unroll
        for (unsigned j = 0; j < 16; ++j) { const unsigned c = xb_ld(&bar[XB_XCNT(j)]); sum += c; cnt += (c > 0u) ? 1u : 0u; mine = (j == x) ? c : mine; }
        if (sum == G) break;
        __builtin_amdgcn_s_sleep(1);
        if ((++sp & 255u) == 0u) { if (xb_ld(&bar[XB_TMO])) break; if (sp > XB_SPIN_CAP) { atomicAdd(&bar[XB_TMO], 1u); break; } }
    }
    nloc = mine > 0u ? mine : 1u; nx = cnt > 0u ? cnt : 1u;
}
__device__ __forceinline__ void xcd_barrier(const XcdBarrier& b) {
    asm volatile("s_waitcnt vmcnt(0)" ::: "memory");
    __syncthreads();
    if (threadIdx.x == 0) {
        unsigned* bar = b.bar;
        __builtin_amdgcn_s_waitcnt(0);
        unsigned nloc = b.st[0], nx = b.st[1];
        if (nloc == 0u) { xcd_barrier_complete(bar, b.x, nloc, nx); b.st[0] = nloc; b.st[1] = nx; }
        const unsigned old = xb_add(&bar[XB_XSUB(b.x)], 1u);
        const unsigned gen = old / nloc;
        if (old + 1u == (gen + 1u) * nloc) {
            __builtin_amdgcn_fence(__ATOMIC_RELEASE, "agent");
            asm volatile("s_waitcnt vmcnt(0)" ::: "memory");
            const unsigned og = xb_add(&bar[XB_TOP], 1u);
            const unsigned tg = og / nx;
            if (og + 1u == (tg + 1u) * nx) xb_add(&bar[XB_TOPGEN], 1u);
            else XB_SPIN(xb_ld(&bar[XB_TOPGEN]) == tg, bar);
            __builtin_amdgcn_fence(__ATOMIC_ACQUIRE, "agent");
            xb_add(&bar[XB_XGEN(b.x)], 1u);
            asm volatile("s_waitcnt vmcnt(0)" ::: "memory");
        } else {
            XB_SPIN(xb_ld(&bar[XB_XGEN(b.x)]) == gen, bar);
            __builtin_amdgcn_fence(__ATOMIC_ACQUIRE, "agent");
            asm volatile("s_waitcnt vmcnt(0)" ::: "memory");
        }
    }
    __syncthreads();
}

namespace pg8 {
constexpr int BM = 256, BK = 64, HALF = 128, HTB = HALF * BK * 2, NXCD = 8, WGM = 8;
__device__ __forceinline__ int lds_byte(int r, int c) { const int st = (r >> 4) * 2 + (c >> 5), rr = r & 15, cc = c & 31, ob = rr * 64 + cc * 2; return st * 1024 + (ob ^ (((ob >> 9) & 1) << 5)); }
__device__ __forceinline__ void stage_rc(int b, int& R, int& C) { const int st = b / 1024, sb = b % 1024, swz = sb ^ (((sb >> 9) & 1) << 5); R = (st >> 1) * 16 + swz / 64; C = (st & 1) * 32 + (swz % 64) / 2; }
__device__ __forceinline__ int perm32(int rho) { const int n = rho >> 4, i = rho & 15; return 8 * (i >> 2) + 4 * n + (i & 3); }
struct Unit { int pm, pn; };
struct Gemm { const bf16_t* A; const bf16_t* Bt; int M, N, K, lda; };
struct StaticOrder {
    int nM, nN, nwg, G, c;
    __device__ void init(int M, int N, int G_, int c_) { nM = M / BM; nN = N / BM; nwg = nM * nN; G = G_; c = c_; }
    __device__ bool next(int i, Unit& u) const {
        const long L = (long)i * G + c; if (L >= nwg) return false;
        int wgid = (int)L; { const int q = nwg / NXCD, r = nwg % NXCD, xcd = wgid % NXCD, off = wgid / NXCD; wgid = (xcd < r ? xcd * (q + 1) : r * (q + 1) + (xcd - r) * q) + off; }
        const int nig = WGM * nN, gid = wgid / nig, fm = gid * WGM, gsz = (nM - fm) < WGM ? (nM - fm) : WGM;
        u.pm = fm + ((wgid % nig) % gsz); u.pn = (wgid % nig) / gsz; return true;
    }
};

template <class Epi>
__device__ __forceinline__ void gemm_phase(LAS unsigned char* lds, const Gemm g, const StaticOrder& S, const Epi& E) {
    const int tid = get_tid(), wid = __builtin_amdgcn_readfirstlane(tid >> 6), lane = tid & 63, wr = wid >> 2, wc = wid & 3, fr = lane & 15, fq = lane >> 4;
    const int K = g.K, nt = K / BK, lda = g.lda;
    unsigned voffA[2], voffB[2];
#pragma unroll
    for (int i = 0; i < 2; ++i) { int R, C; stage_rc(tid * 16 + i * 8192, R, C); const int Rb = (R & ~31) + perm32(R & 31);
        voffA[i] = (unsigned)(R * lda + C) * 2u; voffB[i] = (unsigned)(Rb * K + C) * 2u; }
    const size_t kstep = (size_t)(BK * 2);
    const size_t hstepA = (size_t)HALF * lda * 2, hstepB = (size_t)HALF * K * 2;
    const size_t tstepA = 2 * hstepA, tstepB = 2 * hstepB;
    const unsigned ldsw = (unsigned)wid * 1024u;
    const int aoff = lds_byte(wr * 64 + fr, fq * 8), boff = lds_byte(wc * 32 + fr, fq * 8);
#define PG8_SA(b, h) (((b) * 2 + (h)) * HTB)
#define PG8_SB(b, h) ((4 + (b) * 2 + (h)) * HTB)
#define PG8_STAGE(bufoff, gbase, voff) do { _Pragma("unroll") for (int _i = 0; _i < 2; ++_i) \
        __builtin_amdgcn_global_load_lds((const unsigned*)((const char*)(gbase) + (voff)[_i]), (LAS unsigned*)(lds + (bufoff) + ldsw + _i * 8192), 16, 0, 0); } while (0)
#define PG8_LDA(dst, b, h) do { _Pragma("unroll") for (int m = 0; m < 4; ++m) _Pragma("unroll") for (int k = 0; k < 2; ++k) dst[m][k] = *(const LAS bf16x8*)(lds + PG8_SA(b, h) + aoff + m * 2048 + k * 1024); } while (0)
#define PG8_LDB(dst, b, h) do { _Pragma("unroll") for (int n = 0; n < 2; ++n) _Pragma("unroll") for (int k = 0; k < 2; ++k) dst[n][k] = *(const LAS bf16x8*)(lds + PG8_SB(b, h) + boff + n * 2048 + k * 1024); } while (0)
#define PG8_MMA(ai, bj, At, Bt) do { __builtin_amdgcn_s_setprio(1); _Pragma("unroll") for (int m = 0; m < 4; ++m) _Pragma("unroll") for (int n = 0; n < 2; ++n) _Pragma("unroll") for (int k = 0; k < 2; ++k) \
        acc[ai][bj][m][n] = __builtin_amdgcn_mfma_f32_16x16x32_bf16(Bt[n][k], At[m][k], acc[ai][bj][m][n], 0, 0, 0); __builtin_amdgcn_s_setprio(0); } while (0)
#define PG8_WAIT_V(n) asm volatile("s_waitcnt vmcnt(" #n ")" ::: "memory")
#define PG8_WAIT_L(n) asm volatile("s_waitcnt lgkmcnt(" #n ")" ::: "memory")
#define PG8_BAR __builtin_amdgcn_s_barrier()
#define PG8_SCHED __builtin_amdgcn_sched_barrier(0)
    Unit cur, nxt; int ui = 0;
    if (!S.next(0, cur)) return;
    f32x4 acc[2][2][4][2];
#pragma unroll
    for (int a = 0; a < 2; ++a)
#pragma unroll
        for (int b = 0; b < 2; ++b)
#pragma unroll
            for (int m = 0; m < 4; ++m)
#pragma unroll
                for (int n = 0; n < 2; ++n) acc[a][b][m][n] = zero4();
    bf16x8 At[4][2], B0[2][2], B1[2][2];
    const char* cA = (const char*)g.A + (size_t)cur.pm * tstepA; const char* cB = (const char*)g.Bt + (size_t)cur.pn * tstepB;
    PG8_STAGE(PG8_SB(0, 0), cB, voffB); PG8_STAGE(PG8_SA(0, 0), cA, voffA); PG8_STAGE(PG8_SB(0, 1), cB + hstepB, voffB); PG8_STAGE(PG8_SA(0, 1), cA + hstepA, voffA);
    if (wr == 1) PG8_BAR;
    PG8_WAIT_V(4); PG8_BAR;
    PG8_STAGE(PG8_SB(1, 0), cB + kstep, voffB); PG8_STAGE(PG8_SA(1, 0), cA + kstep, voffA); PG8_STAGE(PG8_SB(1, 1), cB + hstepB + kstep, voffB);
    PG8_WAIT_V(6); PG8_BAR;
    for (;;) {
        const bool has_next = S.next(ui + 1, nxt);
        const char* nA = has_next ? (const char*)g.A + (size_t)nxt.pm * tstepA : cA; const char* nB = has_next ? (const char*)g.Bt + (size_t)nxt.pn * tstepB : cB;
        for (int t = 0; t < nt; t += 2) {
            const bool last = (t == nt - 2);
            const char* a1 = cA + (size_t)(t + 1) * kstep;
            const char* a2 = last ? nA : cA + (size_t)(t + 2) * kstep; const char* b2 = last ? nB : cB + (size_t)(t + 2) * kstep;
            const char* a3 = a2 + kstep; const char* b3 = b2 + kstep;
            PG8_LDB(B0, 0, 0); PG8_SCHED; PG8_LDA(At, 0, 0); PG8_STAGE(PG8_SA(1, 1), a1 + hstepA, voffA);
            PG8_WAIT_L(8); PG8_BAR; PG8_WAIT_L(0); PG8_MMA(0, 0, At, B0); PG8_BAR; PG8_SCHED;
            PG8_LDB(B1, 0, 1); PG8_STAGE(PG8_SB(0, 0), b2, voffB);
            PG8_BAR; PG8_WAIT_L(0); PG8_MMA(0, 1, At, B1); PG8_BAR;
            PG8_LDA(At, 0, 1); PG8_STAGE(PG8_SA(0, 0), a2, voffA);
            PG8_BAR; PG8_WAIT_L(0); PG8_MMA(1, 0, At, B0); PG8_BAR; PG8_SCHED;
            PG8_STAGE(PG8_SB(0, 1), b2 + hstepB, voffB);
            PG8_WAIT_V(6); PG8_BAR; PG8_MMA(1, 1, At, B1); PG8_BAR;
            PG8_LDB(B0, 1, 0); PG8_SCHED; PG8_LDA(At, 1, 0); PG8_STAGE(PG8_SA(0, 1), a2 + hstepA, voffA);
            PG8_WAIT_L(8); PG8_BAR; PG8_WAIT_L(0); PG8_MMA(0, 0, At, B0); PG8_BAR; PG8_SCHED;
            PG8_LDB(B1, 1, 1); PG8_STAGE(PG8_SB(1, 0), b3, voffB);
            PG8_BAR; PG8_WAIT_L(0); PG8_MMA(0, 1, At, B1); PG8_BAR;
            PG8_LDA(At, 1, 1); PG8_STAGE(PG8_SA(1, 0), a3, voffA);
            PG8_BAR; PG8_WAIT_L(0); PG8_MMA(1, 0, At, B0); PG8_BAR; PG8_SCHED;
            PG8_STAGE(PG8_SB(1, 1), b3 + hstepB, voffB);
            PG8_WAIT_V(6); PG8_BAR; PG8_MMA(1, 1, At, B1); PG8_BAR;
        }
        E(acc, cur, wr, wc, fr, fq);
        if (!has_next) break;
#pragma unroll
        for (int a = 0; a < 2; ++a)
#pragma unroll
            for (int b = 0; b < 2; ++b)
#pragma unroll
                for (int m = 0; m < 4; ++m)
#pragma unroll
                    for (int n = 0; n < 2; ++n) acc[a][b][m][n] = zero4();
        cur = nxt; cA = nA; cB = nB; ++ui;
    }
    PG8_WAIT_V(0);
    if (wr == 0) PG8_BAR;
    PG8_BAR;
#undef PG8_SA
#undef PG8_SB
#undef PG8_STAGE
#undef PG8_LDA
#undef PG8_LDB
#undef PG8_MMA
}
}
using pg8::Unit;
typedef f32x4 AccT[2][2][4][2];

__device__ __forceinline__ void epi_inproj(bf16_t* ZX, float* DT, const AccT& acc, const Unit& u, int wr, int wc, int fr, int fq) {
        const int row0 = u.pm * 256 + wr * 64 + fr;
        if (u.pn < 40) {
#pragma unroll
            for (int ai = 0; ai < 2; ++ai)
#pragma unroll
                for (int m = 0; m < 4; ++m) { __builtin_amdgcn_sched_barrier(0); __builtin_amdgcn_sched_barrier(0); bf16_t* rp = ZX + (size_t)(row0 + ai * 128 + m * 16) * ZLD + u.pn * 256 + wc * 32 + 8 * fq;
#pragma unroll
                    for (int bj = 0; bj < 2; ++bj) { const f32x4 v0 = acc[ai][bj][m][0], v1 = acc[ai][bj][m][1];
                        *(u32x4*)(rp + bj * 128) = (u32x4){pk2(v0[0], v0[1]), pk2(v0[2], v0[3]), pk2(v1[0], v1[1]), pk2(v1[2], v1[3])}; } }
        } else if (wc < 2) {
#pragma unroll
            for (int ai = 0; ai < 2; ++ai)
#pragma unroll
                for (int m = 0; m < 4; ++m) { __builtin_amdgcn_sched_barrier(0); __builtin_amdgcn_sched_barrier(0); float* rp = DT + (size_t)(row0 + ai * 128 + m * 16) * 64 + wc * 32 + 8 * fq;
                    *(f32x4*)rp = acc[ai][0][m][0]; *(f32x4*)(rp + 4) = acc[ai][0][m][1]; }
        }
}
__device__ __forceinline__ void epi_resid(float* XR, const float* RS, const AccT& acc, const Unit& u, int wr, int wc, int fr, int fq) {
        const size_t ro0 = (size_t)(u.pm * 256 + wr * 64 + fr) * 2048 + u.pn * 256 + wc * 32 + 8 * fq;
        f32x4 rv[2][4];
#pragma unroll
        for (int q = 0; q < 4; ++q) rv[0][q] = *(const f32x4*)(RS + ro0 + (q >> 1) * 128 + 4 * (q & 1));
#pragma unroll
        for (int it = 0; it < 8; ++it) { const int ai = it >> 2, m = it & 3; const size_t ro = ro0 + (size_t)(ai * 128 + m * 16) * 2048;
            if (it < 7) { const size_t rn = ro0 + (size_t)(((it + 1) >> 2) * 128 + ((it + 1) & 3) * 16) * 2048;
#pragma unroll
                for (int q = 0; q < 4; ++q) rv[(it + 1) & 1][q] = *(const f32x4*)(RS + rn + (q >> 1) * 128 + 4 * (q & 1)); }
            __builtin_amdgcn_sched_barrier(0);
#pragma unroll
            for (int q = 0; q < 4; ++q) *(f32x4*)(XR + ro + (q >> 1) * 128 + 4 * (q & 1)) = rv[it & 1][q] + acc[ai][q >> 1][m][q & 1];
            __builtin_amdgcn_sched_barrier(0); }
}
__device__ __forceinline__ void epi_swiglu(bf16_t* H, const AccT& acc, const Unit& u, int wr, int wc, int fr, int fq) {
        const int row0 = u.pm * 256 + wr * 64 + fr;
#pragma unroll
        for (int ai = 0; ai < 2; ++ai)
#pragma unroll
            for (int m = 0; m < 4; ++m) { __builtin_amdgcn_sched_barrier(0); bf16_t* rp = H + (size_t)(row0 + ai * 128 + m * 16) * FF + u.pn * 128 + wc * 32 + 8 * fq;
                float h[8];
#pragma unroll
                for (int n = 0; n < 2; ++n)
#pragma unroll
                    for (int j = 0; j < 4; ++j) { const float gg = acc[ai][0][m][n][j], uu = acc[ai][1][m][n][j]; h[n * 4 + j] = silu_f(gg) * uu; }
                *(u32x4*)rp = (u32x4){pk2(h[0], h[1]), pk2(h[2], h[3]), pk2(h[4], h[5]), pk2(h[6], h[7])}; }
}
__device__ __forceinline__ void epi_kvq(bf16_t* KB, bf16_t* VB, bf16_t* QB, const float* COS, const float* SIN, float* out, const AccT& acc, const Unit& u, int wr, int wc, int fr, int fq) {
        const int row0 = u.pm * 256 + wr * 64 + fr;
        if (u.pn >= 4 && u.pn < 8) {
#pragma unroll
            for (int ai = 0; ai < 2; ++ai)
#pragma unroll
                for (int m = 0; m < 4; ++m) { __builtin_amdgcn_sched_barrier(0); __builtin_amdgcn_sched_barrier(0); const int row = row0 + ai * 128 + m * 16; const int colb = (u.pn - 4) * 256 + wc * 32 + 8 * fq;
                    float* op = nullptr;
                    if (row < MP) { const int t = row & 4095; if (t >= 2048) op = out + O_PV + ((size_t)(row >> 12) * 2048 + (t - 2048)) * 1024; }
                    else if (row < MV) op = out + O_SV + (size_t)(row - MP) * 1024;
#pragma unroll
                    for (int bj = 0; bj < 2; ++bj) { const f32x4 v0 = acc[ai][bj][m][0], v1 = acc[ai][bj][m][1]; const int col = colb + bj * 128;
                        *(u32x4*)(VB + (size_t)row * 1024 + col) = (u32x4){pk2(v0[0], v0[1]), pk2(v0[2], v0[3]), pk2(v1[0], v1[1]), pk2(v1[2], v1[3])};
                        if (op) { __builtin_nontemporal_store(v0, (f32x4*)(op + col)); __builtin_nontemporal_store(v1, (f32x4*)(op + col + 4)); } } }
        } else {
            const bool isk = u.pn < 4; const int head = (isk ? u.pn : u.pn - 8) * 2 + (wc >> 1); const int d0 = (wc & 1) * 32 + 8 * fq;
            f32x4 cs[2][4];
            { const int row = row0; const int pidx = row < MP ? (row & 4095) : 4096;
              cs[0][0] = *(const f32x4*)(COS + pidx * 64 + d0); cs[0][1] = *(const f32x4*)(COS + pidx * 64 + d0 + 4); cs[0][2] = *(const f32x4*)(SIN + pidx * 64 + d0); cs[0][3] = *(const f32x4*)(SIN + pidx * 64 + d0 + 4); }
#pragma unroll
            for (int it = 0; it < 8; ++it) { const int ai = it >> 2, m = it & 3; const int row = row0 + ai * 128 + m * 16;
                if (it < 7) { const int rown = row0 + ((it + 1) >> 2) * 128 + ((it + 1) & 3) * 16; const int pn_ = rown < MP ? (rown & 4095) : 4096;
                    cs[(it + 1) & 1][0] = *(const f32x4*)(COS + pn_ * 64 + d0); cs[(it + 1) & 1][1] = *(const f32x4*)(COS + pn_ * 64 + d0 + 4);
                    cs[(it + 1) & 1][2] = *(const f32x4*)(SIN + pn_ * 64 + d0); cs[(it + 1) & 1][3] = *(const f32x4*)(SIN + pn_ * 64 + d0 + 4); }
                __builtin_amdgcn_sched_barrier(0);
                const f32x4 c0 = cs[it & 1][0], c1 = cs[it & 1][1], s0 = cs[it & 1][2], s1 = cs[it & 1][3];
                const f32x4 x10 = acc[ai][0][m][0], x11 = acc[ai][0][m][1], x20 = acc[ai][1][m][0], x21 = acc[ai][1][m][1];
                const f32x4 a0 = x10 * c0 - x20 * s0, a1 = x11 * c1 - x21 * s1, b0 = x20 * c0 + x10 * s0, b1 = x21 * c1 + x11 * s1;
                const u32x4 pa = (u32x4){pk2(a0[0], a0[1]), pk2(a0[2], a0[3]), pk2(a1[0], a1[1]), pk2(a1[2], a1[3])};
                const u32x4 pb = (u32x4){pk2(b0[0], b0[1]), pk2(b0[2], b0[3]), pk2(b1[0], b1[1]), pk2(b1[2], b1[3])};
                if (isk) { bf16_t* kp = KB + (size_t)row * 1024 + head * 128 + d0; *(u32x4*)kp = pa; *(u32x4*)(kp + 64) = pb;
                    float* op = nullptr;
                    if (row < MP) { const int t = row & 4095; if (t >= 2048) op = out + O_PK + ((size_t)(row >> 12) * 2048 + (t - 2048)) * 1024; }
                    else if (row < MV) op = out + O_SK + (size_t)(row - MP) * 1024;
                    if (op) { float* q = op + head * 128 + d0; __builtin_nontemporal_store(a0, (f32x4*)q); __builtin_nontemporal_store(a1, (f32x4*)(q + 4)); __builtin_nontemporal_store(b0, (f32x4*)(q + 64)); __builtin_nontemporal_store(b1, (f32x4*)(q + 68)); }
                } else { bf16_t* qp = QB + (size_t)row * 3072 + head * 128 + d0; *(u32x4*)qp = pa; *(u32x4*)(qp + 64) = pb; }
                __builtin_amdgcn_sched_barrier(0); }
        }
}
struct EpiAll {
    int kind; unsigned char* ws; float* out; const float* rs;
    __device__ __forceinline__ void operator()(const AccT& acc, const Unit& u, int wr, int wc, int fr, int fq) const {
        if (kind == 0) epi_inproj((bf16_t*)(ws + B_ZX), (float*)(ws + B_DT), acc, u, wr, wc, fr, fq);
        else if (kind == 1) epi_resid((float*)(ws + B_XR), rs, acc, u, wr, wc, fr, fq);
        else if (kind == 2) epi_swiglu((bf16_t*)(ws + B_H), acc, u, wr, wc, fr, fq);
        else epi_kvq((bf16_t*)(ws + B_KB), (bf16_t*)(ws + B_VB), (bf16_t*)(ws + B_QB), (const float*)(ws + T_COS), (const float*)(ws + T_SIN), out, acc, u, wr, wc, fr, fq);
    }
};
template <class Epi>
__device__ __forceinline__ void run_gemm(unsigned char* smem, const bf16_t* A, int lda, const bf16_t* Bt, int N, int K, const Epi& E) {
    pg8::Gemm g; g.A = A; g.Bt = Bt; g.M = MP; g.N = N; g.K = K; g.lda = lda;
    pg8::StaticOrder S; S.init(MP, N, (int)gridDim.x, (int)blockIdx.x);
    pg8::gemm_phase<Epi>((LAS unsigned char*)smem, g, S, E);
}


__device__ void thin_gemm(CParams& p, unsigned char* smem, const bf16_t* A, int lda, const bf16_t* Bt, int N, int K, int kind, const float* rs_thin) {
    const int tid = get_tid(), lane = tid & 63, w = __builtin_amdgcn_readfirstlane(tid >> 6);
    float* RED = (float*)smem;
    unsigned char* ws = p.ws;
    const int nunits = N >> 5, kw = K >> 3;
    for (int u = get_bid(); u < nunits; u += gridDim.x) {
        const int pn = u >> 3, q = u & 7;
        const bf16_t* b0 = Bt + (size_t)(pn * 256 + 16 * q + (lane & 15)) * K + w * kw + (lane >> 4) * 8;
        const bf16_t* b1 = b0 + (size_t)128 * K;
        const bf16_t* ap = A + (size_t)(MP + (lane & 15)) * lda + w * kw + (lane >> 4) * 8;
        f32x4 acc0 = zero4(), acc1 = zero4();
#pragma unroll 4
        for (int k = 0; k < kw; k += 32) { const bf16x8 av = *(const bf16x8*)(ap + k), w0 = *(const bf16x8*)(b0 + k), w1 = *(const bf16x8*)(b1 + k);
            acc0 = __builtin_amdgcn_mfma_f32_16x16x32_bf16(w0, av, acc0, 0, 0, 0); acc1 = __builtin_amdgcn_mfma_f32_16x16x32_bf16(w1, av, acc1, 0, 0, 0); }
#pragma unroll
        for (int j = 0; j < 4; ++j) { RED[((w * 2 + 0) * 4 + j) * 64 + lane] = acc0[j]; RED[((w * 2 + 1) * 4 + j) * 64 + lane] = acc1[j]; }
        __syncthreads();
        if (tid < 128) {
            const int cl = tid >> 3, r = tid & 7, sl = (cl >> 2) * 16 + r, j = cl & 3; float v0 = 0.f, v1 = 0.f;
#pragma unroll
            for (int ww = 0; ww < 8; ++ww) { v0 += RED[((ww * 2 + 0) * 4 + j) * 64 + sl]; v1 += RED[((ww * 2 + 1) * 4 + j) * 64 + sl]; }
            const int c = 16 * q + cl; const size_t row = MP + r;
            if (kind == 0) { if (pn < 40) { bf16_t* zx = (bf16_t*)(ws + B_ZX) + row * ZLD + pn * 256 + c; zx[0] = f2bf(v0); zx[128] = f2bf(v1); } else if (c < 64) ((float*)(ws + B_DT))[row * 64 + c] = v0; }
            else if (kind == 1) { float* xr = (float*)(ws + B_XR) + row * 2048 + pn * 256 + c; const float* xs = rs_thin + (size_t)r * 2048 + pn * 256 + c; xr[0] = xs[0] + v0; xr[128] = xs[128] + v1; }
            else if (kind == 2) ((bf16_t*)(ws + B_H))[row * FF + pn * 128 + c] = f2bf(silu_f(v0) * v1);
            else if (pn >= 4 && pn < 8) { const int col = (pn - 4) * 256 + c; bf16_t* vb = (bf16_t*)(ws + B_VB) + row * 1024 + col; vb[0] = f2bf(v0); vb[128] = f2bf(v1);
                float* o = p.out + O_SV + (size_t)r * 1024 + col; o[0] = v0; o[128] = v1; }
            else { const bool isk = pn < 4; const int head = (isk ? pn : pn - 8) * 2 + (c >> 6), d = c & 63;
                const float cs = ((const float*)(ws + T_COS))[4096 * 64 + d], sn = ((const float*)(ws + T_SIN))[4096 * 64 + d];
                const float a = v0 * cs - v1 * sn, b = v1 * cs + v0 * sn;
                if (isk) { bf16_t* kb = (bf16_t*)(ws + B_KB) + row * 1024 + head * 128 + d; kb[0] = f2bf(a); kb[64] = f2bf(b); float* o = p.out + O_SK + (size_t)r * 1024 + head * 128 + d; o[0] = a; o[64] = b; }
                else { bf16_t* qb = (bf16_t*)(ws + B_QB) + row * 3072 + head * 128 + d; qb[0] = f2bf(a); qb[64] = f2bf(b); } }
        }
        __syncthreads();
    }
}

struct CvtJob { const float* src; const float* gain; bf16_t* dst; int N, K, kblk, map, nvalid; float scale; };
__device__ __forceinline__ CvtJob cvt_job(CParams& p, int j) {
    CvtJob r; r.gain = nullptr; r.map = 0; r.scale = 1.f;
    unsigned char* ws = p.ws;
    switch (j) {
    case 0: r.src = p.in[7]; r.gain = p.in[6]; r.dst = (bf16_t*)(ws + W_IN); r.N = 10304; r.K = 2048; r.kblk = 32; r.nvalid = 10304; break;
    case 1: r.src = p.in[14]; r.gain = p.in[13]; r.dst = (bf16_t*)(ws + W_OUT); r.N = 2048; r.K = 4096; r.kblk = 64; r.nvalid = 2048; break;
    case 2: r.src = p.in[21]; r.gain = p.in[20]; r.dst = (bf16_t*)(ws + W_GU0); r.N = 11264; r.K = 2048; r.kblk = 32; r.map = 1; r.nvalid = 11264; break;
    case 3: r.src = p.in[22]; r.dst = (bf16_t*)(ws + W_DN0); r.N = 2048; r.K = 5632; r.kblk = 88; r.nvalid = 2048; break;
    case 4: r.src = p.in[16]; r.gain = p.in[15]; r.dst = (bf16_t*)(ws + W_KVQ); r.N = 2048; r.K = 2048; r.kblk = 32; r.map = 3; r.nvalid = 2048; break;
    case 5: r.src = p.in[18]; r.gain = p.in[17]; r.dst = (bf16_t*)(ws + W_KVQ) + (size_t)2048 * 2048; r.N = 3072; r.K = 2048; r.kblk = 32; r.map = 2; r.nvalid = 3072; r.scale = 0.08838834764831845f; break;
    case 6: r.src = p.in[19]; r.dst = (bf16_t*)(ws + W_O); r.N = 2048; r.K = 1024; r.kblk = 16; r.nvalid = 2048; break;
    case 7: r.src = p.in[21] + (size_t)2048 * 11264; r.gain = p.in[20] + 2048; r.dst = (bf16_t*)(ws + W_GU1); r.N = 11264; r.K = 2048; r.kblk = 32; r.map = 1; r.nvalid = 11264; break;
    default: r.src = p.in[22] + (size_t)5632 * 2048; r.dst = (bf16_t*)(ws + W_DN1); r.N = 2048; r.K = 5632; r.kblk = 88; r.nvalid = 2048; break;
    }
    return r;
}
__device__ __forceinline__ int rope_src(int n0) { const int tile = n0 >> 8, within = n0 & 255, half = within >> 7, hh = (within & 127) >> 6; return (tile * 2 + hh) * 128 + half * 64; }

__device__ void convert_tiles(CParams& p, unsigned char* smem, int t0, int tstride, int tend) {
    const int tid = get_tid();
    unsigned* TP = (unsigned*)smem;
    const int n4 = tid & 63, kp = tid >> 6, nloc = 4 * n4;
    f32x4 v0[4], v1[4]; float g0[4], g1[4]; bf16_t* dstp = nullptr; int Kp = 0, n0p = 0, k0p = 0;
#define CVT_LOAD(tile_) do { const int _t = (tile_); int _j = 0; \
        if (_t >= 1312) _j = 1; if (_t >= 1824) _j = 2; if (_t >= 3232) _j = 3; if (_t >= 3936) _j = 4; if (_t >= 4192) _j = 5; if (_t >= 4576) _j = 6; if (_t >= 4704) _j = 7; if (_t >= 6112) _j = 8; \
        const int _jt = _j == 0 ? 0 : _j == 1 ? 1312 : _j == 2 ? 1824 : _j == 3 ? 3232 : _j == 4 ? 3936 : _j == 5 ? 4192 : _j == 6 ? 4576 : _j == 7 ? 4704 : 6112; \
        const CvtJob J = cvt_job(p, _j); const int _lt = _t - _jt; const int _nb = _lt / J.kblk, _kb = _lt % J.kblk; n0p = _nb * 256; k0p = _kb * 64; dstp = J.dst; Kp = J.K; \
        const int _nb64 = n0p + (nloc & ~63); int _sn = _nb64; \
        if (J.map == 1) { const int _pn = _nb64 >> 8, _w = _nb64 & 255; _sn = _w < 128 ? _pn * 128 + _w : FF + _pn * 128 + _w - 128; } \
        else if (J.map == 2) _sn = rope_src(_nb64); else if (J.map == 3) _sn = _nb64 < 1024 ? rope_src(_nb64) : _nb64; \
        _sn += nloc & 63; const bool _valid = _nb64 < J.nvalid; \
        _Pragma("unroll") for (int _i = 0; _i < 4; ++_i) { const int _k = k0p + 2 * (kp + 8 * _i); \
            if (_valid) { v0[_i] = __builtin_nontemporal_load((const f32x4*)(J.src + (size_t)_k * J.N + _sn)); v1[_i] = __builtin_nontemporal_load((const f32x4*)(J.src + (size_t)(_k + 1) * J.N + _sn)); } else { v0[_i] = zero4(); v1[_i] = zero4(); } \
            g0[_i] = J.gain ? J.gain[_k] * J.scale : J.scale; g1[_i] = J.gain ? J.gain[_k + 1] * J.scale : J.scale; } } while (0)
    int tile = t0, buf = 0;
    if (tile < tend) CVT_LOAD(tile);
    while (tile < tend) {
        unsigned* T = TP + buf * (32 * 258);
#pragma unroll
        for (int i = 0; i < 4; ++i) { unsigned* tp = T + (kp + 8 * i) * 258 + nloc;
            *(u32x2*)tp = (u32x2){pk2(v0[i][0] * g0[i], v1[i][0] * g1[i]), pk2(v0[i][1] * g0[i], v1[i][1] * g1[i])};
            *(u32x2*)(tp + 2) = (u32x2){pk2(v0[i][2] * g0[i], v1[i][2] * g1[i]), pk2(v0[i][3] * g0[i], v1[i][3] * g1[i])}; }
        bf16_t* dsto = dstp; const int Ko = Kp, n0o = n0p, k0o = k0p;
        __syncthreads();
        const int nt = tile + tstride;
        if (nt < tend) CVT_LOAD(nt);
#pragma unroll
        for (int i = 0; i < 4; ++i) { const int q = tid + NTHR * i, n = q >> 3, c = q & 7;
            const u32x4 o = (u32x4){T[(4 * c) * 258 + n], T[(4 * c + 1) * 258 + n], T[(4 * c + 2) * 258 + n], T[(4 * c + 3) * 258 + n]};
            *(u32x4*)(dsto + (size_t)(n0o + n) * Ko + k0o + 8 * c) = o; }
        buf ^= 1; tile = nt;
    }
#undef CVT_LOAD
    __syncthreads();
}
__device__ void phase_convert(CParams& p, unsigned char* smem) {
    const int tid = get_tid();
    float* COS = (float*)(p.ws + T_COS); float* SIN = (float*)(p.ws + T_SIN);
    for (int i = get_bid() * NTHR + tid; i < 4097 * 64; i += gridDim.x * NTHR) {
        const int pi = i >> 6, d = i & 63; const float pos = pi < 4096 ? (float)pi : 16384.f;
        const float inv = powf(10000.f, -(float)d / 64.f); const float ang = pos * inv;
        COS[i] = cosf(ang); SIN[i] = sinf(ang);
    }
}

template <int MODE>
__device__ void phase_rmsnorm(CParams& p) {
    const int tid = get_tid(), lane = tid & 63, w = __builtin_amdgcn_readfirstlane(tid >> 6);
    const float* XR = (const float*)(p.ws + B_XR); bf16_t* XN = (bf16_t*)(p.ws + B_XN);
    for (int row = get_bid() * 8 + w; row < MV; row += gridDim.x * 16) {
        const int rowb = row + gridDim.x * 8; const bool hasb = rowb < MV; const int rb = hasb ? rowb : row;
        const float* sa; const float* sb;
        if (MODE == 0) { sa = row < MP ? p.in[0] + (size_t)row * DM : p.in[1] + (size_t)(row - MP) * DM; sb = rb < MP ? p.in[0] + (size_t)rb * DM : p.in[1] + (size_t)(rb - MP) * DM; }
        else { sa = XR + (size_t)row * DM; sb = XR + (size_t)rb * DM; }
        f32x4 va[8], vb[8]; float ssa = 0.f, ssb = 0.f;
#pragma unroll
        for (int i = 0; i < 8; ++i) { va[i] = *(const f32x4*)(sa + lane * 4 + 256 * i); vb[i] = *(const f32x4*)(sb + lane * 4 + 256 * i); }
#pragma unroll
        for (int i = 0; i < 8; ++i) { ssa += va[i][0] * va[i][0] + va[i][1] * va[i][1] + va[i][2] * va[i][2] + va[i][3] * va[i][3]; ssb += vb[i][0] * vb[i][0] + vb[i][1] * vb[i][1] + vb[i][2] * vb[i][2] + vb[i][3] * vb[i][3]; }
        ssa = wave_sum(ssa, lane); ssb = wave_sum(ssb, lane);
        const float s0 = rsqrtf(ssa * (1.f / DM) + EPS), s1 = rsqrtf(ssb * (1.f / DM) + EPS);
#pragma unroll
        for (int i = 0; i < 8; ++i) { const int c = lane * 4 + 256 * i;
            if (MODE == 2) { const f32x4 gn = *(const f32x4*)(p.in[23] + c); *(f32x4*)(p.out + (size_t)row * DM + c) = va[i] * s0 * gn; if (hasb) *(f32x4*)(p.out + (size_t)rowb * DM + c) = vb[i] * s1 * gn; }
            else { *(u32x2*)(XN + (size_t)row * DM + c) = (u32x2){pk2(va[i][0] * s0, va[i][1] * s0), pk2(va[i][2] * s0, va[i][3] * s0)};
                if (hasb) *(u32x2*)(XN + (size_t)rowb * DM + c) = (u32x2){pk2(vb[i][0] * s1, vb[i][1] * s1), pk2(vb[i][2] * s1, vb[i][3] * s1)}; } }
    }
}

__device__ __forceinline__ void ssd_prep(CParams& p, float* ACS, float* DTV, float* WSC, float* CD, int b, int c, int g) {
    const int tid = get_tid(), lane = tid & 63, w = __builtin_amdgcn_readfirstlane(tid >> 6), hd = g * 8 + w;
    const float* DT = (const float*)(p.ws + B_DT); const int row0 = b * SEQ + c * 128;
    const float bias = p.in[10][hd], A = -__expf(p.in[11][hd]);
    const float d0 = softplus_f(DT[(size_t)(row0 + 2 * lane) * 64 + hd] + bias), d1 = softplus_f(DT[(size_t)(row0 + 2 * lane + 1) * 64 + hd] + bias);
    const float a0 = d0 * A, a1 = d1 * A, s = a0 + a1; float incl = s;
    for (int o = 1; o < 64; o <<= 1) { const float t = shl(incl, (lane - o) & 63); if (lane >= o) incl += t; }
    const float excl = incl - s, c0 = excl + a0, c1 = excl + s, tot = shl(incl, 63);
    ACS[w * 128 + 2 * lane] = c0; ACS[w * 128 + 2 * lane + 1] = c1; DTV[w * 128 + 2 * lane] = d0; DTV[w * 128 + 2 * lane + 1] = d1;
    if (WSC) { WSC[w * 128 + 2 * lane] = d0 * __expf(tot - c0); WSC[w * 128 + 2 * lane + 1] = d1 * __expf(tot - c1); }
    if (CD && lane == 0) CD[(b * 32 + c) * 64 + hd] = __expf(tot);
}
template <int NC, bool TRANS>
__device__ __forceinline__ void stage_conv(bf16_t* dst, const bf16_t* src, bool first, const float* cw, const float* cb, const float* rowscale) {
    constexpr int CP = NC / 2, RG = NTHR / CP, RPT = 128 / RG;
    const int tid = get_tid(), cp = tid % CP, rg = tid / CP, ch = 2 * cp, r0 = rg * RPT;
    float w[4][2], bb[2];
#pragma unroll
    for (int k = 0; k < 4; ++k) { w[k][0] = cw[k * CONVD + ch]; w[k][1] = cw[k * CONVD + ch + 1]; }
    bb[0] = cb[ch]; bb[1] = cb[ch + 1];
    float xa[2], xb[2], xc[2];
#define LDROW(r, o) do { if (first && (r) < 0) { o[0] = 0.f; o[1] = 0.f; } else { const unsigned _v = *(const unsigned*)(src + (long)(r) * ZLD + ch); o[0] = bf2f(_v & 0xffffu); o[1] = bf2f(_v >> 16); } } while (0)
    LDROW(r0 - 3, xa); LDROW(r0 - 2, xb); LDROW(r0 - 1, xc);
    float ov[2][RPT];
#pragma unroll
    for (int i = 0; i < RPT; ++i) {
        float xd[2]; LDROW(r0 + i, xd);
#pragma unroll
        for (int e = 0; e < 2; ++e) { float v = bb[e] + w[0][e] * xa[e] + w[1][e] * xb[e] + w[2][e] * xc[e] + w[3][e] * xd[e]; v = silu_f(v);
            if (TRANS && rowscale) v *= rowscale[(ch >> 6) * 128 + r0 + i];
            ov[e][i] = v; xa[e] = xb[e]; xb[e] = xc[e]; xc[e] = xd[e]; }
        if (!TRANS) *(unsigned*)(dst + (r0 + i) * 136 + ch) = pk2(ov[0][i], ov[1][i]);
    }
#undef LDROW
    if (TRANS) {
#pragma unroll
        for (int e = 0; e < 2; ++e)
#pragma unroll
            for (int q = 0; q < RPT / 8; ++q)
                *(u32x4*)(dst + (ch + e) * 136 + r0 + q * 8) = (u32x4){pk2(ov[e][q * 8], ov[e][q * 8 + 1]), pk2(ov[e][q * 8 + 2], ov[e][q * 8 + 3]), pk2(ov[e][q * 8 + 4], ov[e][q * 8 + 5]), pk2(ov[e][q * 8 + 6], ov[e][q * 8 + 7])};
    }
}

__device__ __forceinline__ void conv_from_raw(bf16_t* dst, const unsigned (&raw)[19], const float* cw, const float* cb, const float* rowscale, int ch, int r0) {
    float w[4][2], bb[2];
#pragma unroll
    for (int k = 0; k < 4; ++k) { w[k][0] = cw[k * CONVD + ch]; w[k][1] = cw[k * CONVD + ch + 1]; }
    bb[0] = cb[ch]; bb[1] = cb[ch + 1];
    float ov[2][16];
#pragma unroll
    for (int i = 0; i < 16; ++i)
#pragma unroll
        for (int e = 0; e < 2; ++e) { float v = bb[e];
#pragma unroll
            for (int k = 0; k < 4; ++k) { const unsigned xr = raw[i + k]; v += w[k][e] * (e ? bf2f(xr >> 16) : bf2f(xr & 0xffffu)); }
            v = silu_f(v); if (rowscale) v *= rowscale[(ch >> 6) * 128 + r0 + i]; ov[e][i] = v; }
#pragma unroll
    for (int e = 0; e < 2; ++e)
#pragma unroll
        for (int q = 0; q < 2; ++q)
            *(u32x4*)(dst + (ch + e) * 136 + r0 + q * 8) = (u32x4){pk2(ov[e][q * 8], ov[e][q * 8 + 1]), pk2(ov[e][q * 8 + 2], ov[e][q * 8 + 3]), pk2(ov[e][q * 8 + 4], ov[e][q * 8 + 5]), pk2(ov[e][q * 8 + 6], ov[e][q * 8 + 7])};
}
__device__ __forceinline__ void conv_from_raw_nat(bf16_t* dst, const unsigned (&raw)[19], const float* cw, const float* cb, int ch, int r0) {
    float w[4][2], bb[2];
#pragma unroll
    for (int k = 0; k < 4; ++k) { w[k][0] = cw[k * CONVD + ch]; w[k][1] = cw[k * CONVD + ch + 1]; }
    bb[0] = cb[ch]; bb[1] = cb[ch + 1];
#pragma unroll
    for (int i = 0; i < 16; ++i) { float v[2];
#pragma unroll
        for (int e = 0; e < 2; ++e) { float t = bb[e];
#pragma unroll
            for (int k = 0; k < 4; ++k) { const unsigned xr = raw[i + k]; t += w[k][e] * (e ? bf2f(xr >> 16) : bf2f(xr & 0xffffu)); }
            v[e] = silu_f(t); }
        *(unsigned*)(dst + (r0 + i) * 136 + ch) = pk2(v[0], v[1]); }
}
__device__ void ssd_state_item(CParams& p, unsigned char* smem, int b, int c, int g) {
    const int tid = get_tid(), lane = tid & 63, w = __builtin_amdgcn_readfirstlane(tid >> 6);
    float* ACS = (float*)smem; float* DTV = ACS + 1024; float* WSC = DTV + 1024;
    bf16_t* BT = (bf16_t*)(smem + 12288); bf16_t* XT = (bf16_t*)(smem + 47104);
    const bf16_t* ZX = (const bf16_t*)(p.ws + B_ZX); bf16_t* ST = (bf16_t*)(p.ws + B_ST); float* CD = (float*)(p.ws + B_CD);
    const bf16_t* zrow = ZX + (size_t)(b * SEQ + c * 128) * ZLD + DIN;
    const int ch = 2 * (tid & 63), r0 = (tid >> 6) * 16;
    unsigned rawB[19], rawX[4][19];
#define LOADROWS(dst_, src_) do { _Pragma("unroll") for (int _i = 0; _i < 19; ++_i) { const int _r = r0 - 3 + _i; dst_[_i] = (c == 0 && _r < 0) ? 0u : *(const unsigned*)((src_) + (long)_r * ZLD + ch); } } while (0)
    LOADROWS(rawB, zrow + DIN + g * 128);
#pragma unroll
    for (int q = 0; q < 4; ++q) LOADROWS(rawX[q], zrow + g * 512 + q * 128);
#undef LOADROWS
    ssd_prep(p, ACS, DTV, WSC, CD, b, c, g);
    conv_from_raw(BT, rawB, p.in[8] + DIN + g * 128, p.in[9] + DIN + g * 128, nullptr, ch, r0);
    __syncthreads();
#pragma unroll
    for (int hb = 0; hb < 2; ++hb) {
        const int ch0 = g * 512 + hb * 256;
        conv_from_raw(XT, rawX[2 * hb], p.in[8] + ch0, p.in[9] + ch0, WSC + (hb * 4) * 128, ch, r0);
        conv_from_raw(XT + 128 * 136, rawX[2 * hb + 1], p.in[8] + ch0 + 128, p.in[9] + ch0 + 128, WSC + (hb * 4 + 2) * 128, ch, r0);
        __syncthreads();
        f32x4 acc[2][8];
#pragma unroll
        for (int i = 0; i < 2; ++i)
#pragma unroll
            for (int n = 0; n < 8; ++n) acc[i][n] = zero4();
#pragma unroll
        for (int ks = 0; ks < 4; ++ks) {
            const bf16x8 a0 = frag_ld(XT, 136, 32 * w, 32 * ks, lane), a1 = frag_ld(XT, 136, 32 * w + 16, 32 * ks, lane); bf16x8 bfr[8];
#pragma unroll
            for (int n = 0; n < 8; ++n) bfr[n] = frag_ld(BT, 136, 16 * n, 32 * ks, lane);
            __builtin_amdgcn_sched_barrier(0);
#pragma unroll
            for (int n = 0; n < 8; ++n) {
                acc[0][n] = __builtin_amdgcn_mfma_f32_16x16x32_bf16(bfr[n], a0, acc[0][n], 0, 0, 0);
                acc[1][n] = __builtin_amdgcn_mfma_f32_16x16x32_bf16(bfr[n], a1, acc[1][n], 0, 0, 0); }
        }
#pragma unroll
        for (int i = 0; i < 2; ++i) { const int pp = 32 * w + 16 * i + (lane & 15); const int hd = g * 8 + hb * 4 + (pp >> 6);
            bf16_t* sp = ST + ((size_t)((b * 32 + c) * 64 + hd) * 64 + (pp & 63)) * 128 + (lane >> 4) * 4;
#pragma unroll
            for (int n = 0; n < 8; ++n) *(u32x2*)(sp + 16 * n) = (u32x2){pk2(acc[i][n][0], acc[i][n][1]), pk2(acc[i][n][2], acc[i][n][3])}; }
        __syncthreads();
    }
}

__device__ void ssd_sample_item(CParams& p, unsigned char* smem, int bs, int hd) {
    const int tid = get_tid(), lane = tid & 63;
    float* XS = (float*)smem; float* BS = XS + 64; float* CS = BS + 128;
    bf16_t* ZX = (bf16_t*)(p.ws + B_ZX); const float* DT = (const float*)(p.ws + B_DT);
    bf16_t* zxrow = ZX + (size_t)(MP + bs) * ZLD; const int g = hd >> 3;
    const int pp = tid >> 3, nc = (tid & 7) * 16; const size_t off = (((size_t)bs * 64 + hd) * 64 + pp) * 128 + nc;
    f32x4 h[4];
#pragma unroll
    for (int i = 0; i < 4; ++i) h[i] = __builtin_nontemporal_load((const f32x4*)(p.in[3] + off + 4 * i));
    if (tid < 320) { const int ch = tid < 64 ? hd * 64 + tid : (tid < 192 ? DIN + g * 128 + tid - 64 : DIN + 1024 + g * 128 + tid - 192);
        const float* sc = p.in[2] + (size_t)bs * 3 * CONVD; const float* cw = p.in[8];
        const float v = p.in[9][ch] + cw[ch] * sc[ch] + cw[CONVD + ch] * sc[CONVD + ch] + cw[2 * CONVD + ch] * sc[2 * CONVD + ch] + cw[3 * CONVD + ch] * bf2f(zxrow[DIN + ch]);
        XS[tid] = silu_f(v); }
    const float dt = softplus_f(DT[(size_t)(MP + bs) * 64 + hd] + p.in[10][hd]); const float dae = __expf(dt * -__expf(p.in[11][hd]));
    __syncthreads();
    const float xd = dt * XS[pp]; float y = 0.f;
#pragma unroll
    for (int i = 0; i < 4; ++i) { const f32x4 bv = *(const f32x4*)(BS + nc + 4 * i), cv = *(const f32x4*)(CS + nc + 4 * i);
        h[i] = h[i] * dae + xd * bv; __builtin_nontemporal_store(h[i], (f32x4*)(p.out + O_SSSM + off + 4 * i));
        y += h[i][0] * cv[0] + h[i][1] * cv[1] + h[i][2] * cv[2] + h[i][3] * cv[3]; }
    y += SHX(y, 1); y += SHX(y, 2); y += SHX(y, 4);
    if ((tid & 7) == 0) { y += p.in[12][hd] * XS[pp]; const float z = bf2f(zxrow[hd * 64 + pp]); zxrow[hd * 64 + pp] = f2bf(y * silu_f(z)); }
    __syncthreads();
}

__device__ void phase_ssd_states(CParams& p, unsigned char* smem) {
    for (int it = get_bid(); it < 1024; it += gridDim.x) {
        if (it < 512) ssd_state_item(p, smem, it >> 8, (it >> 3) & 31, it & 7);
        else ssd_sample_item(p, smem, (it - 512) >> 6, (it - 512) & 63);
    }
    const bf16_t* ZX = (const bf16_t*)(p.ws + B_ZX);
    for (int i = get_bid() * NTHR + get_tid(); i < 2 * 3 * CONVD; i += gridDim.x * NTHR) { const int b = i / (3 * CONVD), r = (i / CONVD) % 3, ch = i % CONVD;
        p.out[O_PCONV + i] = bf2f(ZX[(size_t)(b * SEQ + SEQ - 3 + r) * ZLD + DIN + ch]); }
    for (int i = get_bid() * NTHR + get_tid(); i < 8 * 3 * CONVD; i += gridDim.x * NTHR) { const int bs = i / (3 * CONVD), r = (i / CONVD) % 3, ch = i % CONVD;
        p.out[O_SCONV + i] = r < 2 ? p.in[2][(size_t)(bs * 3 + r + 1) * CONVD + ch] : bf2f(ZX[(size_t)(MP + bs) * ZLD + DIN + ch]); }
}

__device__ void phase_scan(CParams& p) {
    const bf16_t* ST = (const bf16_t*)(p.ws + B_ST); bf16_t* HPV = (bf16_t*)(p.ws + B_HPV); const float* CD = (const float*)(p.ws + B_CD);
    for (int i = get_bid() * NTHR + get_tid(); i < 2 * 64 * 1024; i += gridDim.x * NTHR) {
        const int b = i >> 16, rem = i & 65535, hd = rem >> 10, e8 = rem & 1023;
        float h[8];
#pragma unroll
        for (int e = 0; e < 8; ++e) h[e] = 0.f;
        for (int c0 = 0; c0 < 32; c0 += 8) {
            u32x4 v[8];
#pragma unroll
            for (int k = 0; k < 8; ++k) v[k] = *(const u32x4*)(ST + ((size_t)((b * 32 + c0 + k) * 64 + hd)) * 8192 + e8 * 8);
#pragma unroll
            for (int k = 0; k < 8; ++k) { const float cd = CD[(b * 32 + c0 + k) * 64 + hd];
                *(u32x4*)(HPV + ((size_t)((b * 32 + c0 + k) * 64 + hd)) * 8192 + e8 * 8) = (u32x4){pk2(h[0], h[1]), pk2(h[2], h[3]), pk2(h[4], h[5]), pk2(h[6], h[7])};
#pragma unroll
                for (int e = 0; e < 4; ++e) { h[2 * e] = h[2 * e] * cd + bf2f(v[k][e] & 0xffffu); h[2 * e + 1] = h[2 * e + 1] * cd + bf2f(v[k][e] >> 16); } }
        }
        float* o = p.out + O_PSSM + ((size_t)(b * 64 + hd)) * 8192 + e8 * 8;
        *(f32x4*)o = (f32x4){h[0], h[1], h[2], h[3]}; *(f32x4*)(o + 4) = (f32x4){h[4], h[5], h[6], h[7]};
    }
}

__device__ void ssd_out_item(CParams& p, unsigned char* smem, int b, int c, int g) {
    const int tid = get_tid(), lane = tid & 63, w = __builtin_amdgcn_readfirstlane(tid >> 6);
    float* ACS = (float*)smem; float* DTV = ACS + 1024;
    bf16_t* CL = (bf16_t*)(smem + 8192); bf16_t* BL = (bf16_t*)(smem + 43008); bf16_t* CB = (bf16_t*)(smem + 77824);
    bf16_t* XT = BL; bf16_t* HP = BL + 64 * 136;
    bf16_t* ZX = (bf16_t*)(p.ws + B_ZX); const bf16_t* ST = (const bf16_t*)(p.ws + B_HPV); float* GS = (float*)(p.ws + B_GS);
    const int row0 = b * SEQ + c * 128;
    const bf16_t* zrow = ZX + (size_t)row0 * ZLD + DIN;
    const int chq = 2 * (tid & 63), r0q = (tid >> 6) * 16;
    unsigned rawC[19], rawBq[19];
#pragma unroll
    for (int i = 0; i < 19; ++i) { const int r = r0q - 3 + i; const bool zr = (c == 0 && r < 0);
        rawC[i] = zr ? 0u : *(const unsigned*)(zrow + DIN + 1024 + g * 128 + (long)r * ZLD + chq);
        rawBq[i] = zr ? 0u : *(const unsigned*)(zrow + DIN + g * 128 + (long)r * ZLD + chq); }
    ssd_prep(p, ACS, DTV, nullptr, nullptr, b, c, g);
    conv_from_raw_nat(CL, rawC, p.in[8] + DIN + 1024 + g * 128, p.in[9] + DIN + 1024 + g * 128, chq, r0q);
    conv_from_raw_nat(BL, rawBq, p.in[8] + DIN + g * 128, p.in[9] + DIN + g * 128, chq, r0q);
    __syncthreads();
    {
        f32x4 cacc[8];
#pragma unroll
        for (int n = 0; n < 8; ++n) cacc[n] = zero4();
#pragma unroll
        for (int ks = 0; ks < 4; ++ks) { const bf16x8 a = frag_ld(CL, 136, 16 * w, 32 * ks, lane);
#pragma unroll
            for (int n = 0; n < 8; ++n) if (n <= (w | 1)) { const bf16x8 bf = frag_ld(BL, 136, 16 * n, 32 * ks, lane); cacc[n] = __builtin_amdgcn_mfma_f32_16x16x32_bf16(a, bf, cacc[n], 0, 0, 0); } }
#pragma unroll
        for (int n = 0; n < 8; ++n) if (n <= (w | 1)) {
#pragma unroll
            for (int j = 0; j < 4; ++j) CB[(16 * w + (lane >> 4) * 4 + j) * 136 + 16 * n + (lane & 15)] = f2bf(cacc[n][j]); }
    }
    __syncthreads();
    float ssq = 0.f;
    const int l_a = 16 * w + (lane & 15);
    const int kmax = (16 * w + 15) >> 5;
    const int cpx = tid & 31, rgx = tid >> 5, chx = 2 * cpx, r0x = rgx * 8;
    const int ppx = tid >> 3, ncx = (tid & 7) * 16;
    unsigned xraw[11]; u32x4 hraw[2]; u32x2 zraw[4];
#define SSD_PREFETCH(rr) do { const int _hd = g * 8 + (rr); const bf16_t* _src = zrow + _hd * 64 + chx; \
        _Pragma("unroll") for (int _i = 0; _i < 11; ++_i) { const int _r = r0x - 3 + _i; xraw[_i] = (c == 0 && _r < 0) ? 0u : *(const unsigned*)(_src + (long)_r * ZLD); } \
        const bf16_t* _hp = ST + ((size_t)((b * 32 + c) * 64 + _hd) * 64 + ppx) * 128 + ncx; hraw[0] = *(const u32x4*)_hp; hraw[1] = *(const u32x4*)(_hp + 8); \
        { const bf16_t* _zr = ZX + (size_t)(row0 + 16 * w + (lane & 15)) * ZLD + _hd * 64 + (lane >> 4) * 4; \
            _Pragma("unroll") for (int _pt = 0; _pt < 4; ++_pt) zraw[_pt] = *(const u32x2*)(_zr + 16 * _pt); } } while (0)
    SSD_PREFETCH(0);
    for (int r = 0; r < 8; ++r) {
        const int hd = g * 8 + r;
        {
            const float* cw = p.in[8] + hd * 64 + chx; const float* cb = p.in[9] + hd * 64 + chx;
            float wv[4][2], bb[2];
#pragma unroll
            for (int k = 0; k < 4; ++k) { wv[k][0] = cw[k * CONVD]; wv[k][1] = cw[k * CONVD + 1]; }
            bb[0] = cb[0]; bb[1] = cb[1];
            float ov[2][8];
#pragma unroll
            for (int i = 0; i < 8; ++i)
#pragma unroll
                for (int e = 0; e < 2; ++e) { float v = bb[e];
#pragma unroll
                    for (int k = 0; k < 4; ++k) { const unsigned xr = xraw[i + k]; v += wv[k][e] * (e ? bf2f(xr >> 16) : bf2f(xr & 0xffffu)); }
                    ov[e][i] = silu_f(v); }
#pragma unroll
            for (int e = 0; e < 2; ++e)
                *(u32x4*)(XT + (chx + e) * 136 + r0x) = (u32x4){pk2(ov[e][0], ov[e][1]), pk2(ov[e][2], ov[e][3]), pk2(ov[e][4], ov[e][5]), pk2(ov[e][6], ov[e][7])};
            *(u32x4*)(HP + ppx * 136 + ncx) = hraw[0]; *(u32x4*)(HP + ppx * 136 + ncx + 8) = hraw[1];
        }
        u32x2 zcur[4];
#pragma unroll
        for (int i = 0; i < 4; ++i) zcur[i] = zraw[i];
        __syncthreads();
        if (r < 7) SSD_PREFETCH(r + 1);
        f32x4 acc[4];
#pragma unroll
        for (int pt = 0; pt < 4; ++pt) acc[pt] = zero4();
#pragma unroll
        for (int ks = 0; ks < 4; ++ks) { const bf16x8 a = frag_ld(CL, 136, 16 * w, 32 * ks, lane); bf16x8 hf[4];
#pragma unroll
            for (int pt = 0; pt < 4; ++pt) hf[pt] = frag_ld(HP, 136, 16 * pt, 32 * ks, lane);
            __builtin_amdgcn_sched_barrier(0);
#pragma unroll
            for (int pt = 0; pt < 4; ++pt) acc[pt] = __builtin_amdgcn_mfma_f32_16x16x32_bf16(hf[pt], a, acc[pt], 0, 0, 0); }
        { const float e = __expf(ACS[r * 128 + l_a]);
#pragma unroll
          for (int pt = 0; pt < 4; ++pt) acc[pt] = acc[pt] * e; }
        const float acl = ACS[r * 128 + l_a];
        for (int ks = 0; ks <= kmax; ++ks) {
            const int s0 = 32 * ks + (lane >> 4) * 8;
            const bf16x8 cbv = *(const bf16x8*)(CB + l_a * 136 + s0);
            const f32x4 as0 = *(const f32x4*)(ACS + r * 128 + s0), as1 = *(const f32x4*)(ACS + r * 128 + s0 + 4);
            const f32x4 dt0 = *(const f32x4*)(DTV + r * 128 + s0), dt1 = *(const f32x4*)(DTV + r * 128 + s0 + 4);
            float vv[8];
#pragma unroll
            for (int i = 0; i < 8; ++i) { const float asv = i < 4 ? as0[i & 3] : as1[i & 3]; const float dtv = i < 4 ? dt0[i & 3] : dt1[i & 3];
                const float x = bf2f((unsigned)(unsigned short)cbv[i]) * __expf(fminf(acl - asv, 0.f)) * dtv; vv[i] = (s0 + i <= l_a) ? x : 0.f; }
            const u32x4 au = (u32x4){pk2(vv[0], vv[1]), pk2(vv[2], vv[3]), pk2(vv[4], vv[5]), pk2(vv[6], vv[7])};
            bf16x8 a; __builtin_memcpy(&a, &au, 16);
            bf16x8 xf[4];
#pragma unroll
            for (int pt = 0; pt < 4; ++pt) xf[pt] = frag_ld(XT, 136, 16 * pt, 32 * ks, lane);
            __builtin_amdgcn_sched_barrier(0);
#pragma unroll
            for (int pt = 0; pt < 4; ++pt) acc[pt] = __builtin_amdgcn_mfma_f32_16x16x32_bf16(xf[pt], a, acc[pt], 0, 0, 0);
        }
        const float Dh = p.in[12][hd];
        { bf16_t* zr = ZX + (size_t)(row0 + l_a) * ZLD + hd * 64 + (lane >> 4) * 4;
#pragma unroll
          for (int pt = 0; pt < 4; ++pt) { float y[4];
#pragma unroll
              for (int j = 0; j < 4; ++j) { const int pp = 16 * pt + (lane >> 4) * 4 + j; const float xs = bf2f(XT[pp * 136 + l_a]);
                  const unsigned zw = zcur[pt][j >> 1]; const float z = (j & 1) ? bf2f(zw >> 16) : bf2f(zw & 0xffffu);
                  y[j] = (acc[pt][j] + Dh * xs) * silu_f(z); ssq += y[j] * y[j]; }
              *(u32x2*)(zr + 16 * pt) = (u32x2){pk2(y[0], y[1]), pk2(y[2], y[3])}; } }
        __syncthreads();
    }
#undef SSD_PREFETCH
    { float sq = ssq; sq += SHX(sq, 16); sq += SHX(sq, 32);
      if ((lane >> 4) == 0) GS[(size_t)(row0 + l_a) * 8 + g] = rsqrtf(sq * (1.f / 512.f) + EPS); }
}
__device__ void phase_ssd_out(CParams& p, unsigned char* smem) {
    for (int it = get_bid(); it < 512; it += gridDim.x) { ssd_out_item(p, smem, it >> 8, (it >> 3) & 31, it & 7); __syncthreads(); }
}
__device__ void phase_gnorm(CParams& p) {
    const int tid = get_tid(), lane = tid & 63, w = __builtin_amdgcn_readfirstlane(tid >> 6);
    bf16_t* ZX = (bf16_t*)(p.ws + B_ZX); const float* GS = (const float*)(p.ws + B_GS);
    for (int row = get_bid() * 8 + w; row < MV; row += gridDim.x * 8) {
#pragma unroll
        for (int i = 0; i < 8; ++i) { const int ch = (lane + 64 * i) * 8;
            u32x4* q = (u32x4*)(ZX + (size_t)row * ZLD + ch); const u32x4 v = *q; u32x4 o; float s;
            if (row < MP) s = GS[(size_t)row * 8 + i];
            else { float ss = 0.f;
#pragma unroll
                for (int e = 0; e < 4; ++e) { const float a = bf2f(v[e] & 0xffffu), b = bf2f(v[e] >> 16); ss += a * a + b * b; }
                ss = wave_sum(ss, lane); s = rsqrtf(ss * (1.f / 512.f) + EPS); }
#pragma unroll
            for (int e = 0; e < 4; ++e) o[e] = pk2(bf2f(v[e] & 0xffffu) * s, bf2f(v[e] >> 16) * s);
            *q = o; }
    }
}

struct AttStep { int it, kb, qb, g, h, rate, rowbase, ok; };
__device__ __forceinline__ void att_decode(AttStep& s) {
    s.ok = s.it < 1536 ? 1 : 0; if (!s.ok) return;
    const int bh = s.it / 96, r = s.it % 96; const int b = bh >> 3; s.h = bh & 7; int rho;
    if (r < 32) { s.g = 0; rho = 0; s.qb = r; } else if (r < 64) { s.g = 1; rho = (r - 32) >> 3; s.qb = (r - 32) & 7; } else { s.g = 2; rho = (r - 64) >> 1; s.qb = (r - 64) & 1; }
    s.rate = s.g == 0 ? 1 : (s.g == 1 ? 4 : 16); s.rowbase = b * SEQ + rho; s.kb = s.qb > 0 ? s.qb - 1 : 0;
}
__device__ void attn_prompt(CParams& p, unsigned char* smem) {
    const int tid = get_tid(), lane = tid & 63, w = __builtin_amdgcn_readfirstlane(tid >> 6);
    bf16_t* KT = (bf16_t*)smem; bf16_t* VT = (bf16_t*)(smem + 34816); bf16_t* PW = (bf16_t*)(smem + 69632) + w * 16 * 136;
    const bf16_t* KB = (const bf16_t*)(p.ws + B_KB); const bf16_t* VB = (const bf16_t*)(p.ws + B_VB); const bf16_t* QB = (const bf16_t*)(p.ws + B_QB);
    bf16_t* OP = (bf16_t*)(p.ws + B_OP); float* LSE = (float*)(p.ws + B_LSE);
    AttStep cur; cur.it = get_bid(); att_decode(cur);
    u32x4 kraw[4], vraw[4];
#define ATT_PREFETCH(S) do { \
        _Pragma("unroll") for (int _i = 0; _i < 4; ++_i) { const int _idx = tid + NTHR * _i, _key = _idx >> 4, _chn = _idx & 15; \
            kraw[_i] = *(const u32x4*)(KB + (size_t)((S).rowbase + (S).rate * (128 * (S).kb + _key)) * 1024 + (S).h * 128 + _chn * 8); } \
        { const int _kp = tid & 63, _dq = tid >> 6; const bf16_t* _v0 = VB + (size_t)((S).rowbase + (S).rate * (128 * (S).kb + 2 * _kp)) * 1024 + (S).h * 128 + _dq * 16; const bf16_t* _v1 = _v0 + (size_t)(S).rate * 1024; \
          vraw[0] = *(const u32x4*)_v0; vraw[1] = *(const u32x4*)(_v0 + 8); vraw[2] = *(const u32x4*)_v1; vraw[3] = *(const u32x4*)(_v1 + 8); } } while (0)
    bf16x8 qnext[4];
#define ATT_QPREFETCH(S) do { const size_t _qrow = (size_t)((S).rowbase + (S).rate * (128 * (S).qb + 16 * w + (lane & 15))); \
        _Pragma("unroll") for (int _ks = 0; _ks < 4; ++_ks) qnext[_ks] = *(const bf16x8*)(QB + _qrow * 3072 + ((S).g * 8 + (S).h) * 128 + 32 * _ks + (lane >> 4) * 8); } while (0)
    if (cur.ok) { ATT_PREFETCH(cur); ATT_QPREFETCH(cur); }
    bf16x8 qf[4]; float mrow[4], lrow[4]; f32x4 o[8];
    while (cur.ok) {
#pragma unroll
        for (int i = 0; i < 4; ++i) { const int idx = tid + NTHR * i, key = idx >> 4, chn = idx & 15; *(u32x4*)(KT + key * 136 + chn * 8) = kraw[i]; }
        { const int kp = tid & 63, dq = tid >> 6;
#pragma unroll
          for (int i = 0; i < 2; ++i)
#pragma unroll
              for (int e = 0; e < 4; ++e) { const unsigned a = vraw[i][e], b = vraw[2 + i][e]; const int d = dq * 16 + 8 * i + 2 * e;
                  *(unsigned*)(VT + d * 136 + 2 * kp) = (a & 0xffffu) | (b << 16); *(unsigned*)(VT + (d + 1) * 136 + 2 * kp) = (a >> 16) | (b & 0xffff0000u); } }
        __syncthreads();
        AttStep nxt = cur;
        if (cur.kb < cur.qb) nxt.kb = cur.kb + 1; else { nxt.it = cur.it + gridDim.x; att_decode(nxt); }
        const bool first = cur.kb == (cur.qb > 0 ? cur.qb - 1 : 0), last = cur.kb == cur.qb;
        if (first) {
#pragma unroll
            for (int ks = 0; ks < 4; ++ks) qf[ks] = qnext[ks];
        }
        if (nxt.ok) { ATT_PREFETCH(nxt); if (nxt.it != cur.it) ATT_QPREFETCH(nxt); }
        if (first) {
#pragma unroll
            for (int j = 0; j < 4; ++j) { mrow[j] = -1e30f; lrow[j] = 0.f; }
#pragma unroll
            for (int dt = 0; dt < 8; ++dt) o[dt] = zero4();
        }
        const int dsgn = last ? 1 : -1;
        f32x4 s[8];
#pragma unroll
        for (int kt = 0; kt < 8; ++kt) s[kt] = zero4();
#pragma unroll
        for (int ks = 0; ks < 4; ++ks) { bf16x8 kf[8];
#pragma unroll
            for (int kt = 0; kt < 8; ++kt) kf[kt] = frag_ld(KT, 136, 16 * kt, 32 * ks, lane);
            __builtin_amdgcn_sched_barrier(0);
#pragma unroll
            for (int kt = 0; kt < 8; ++kt) s[kt] = __builtin_amdgcn_mfma_f32_16x16x32_bf16(qf[ks], kf[kt], s[kt], 0, 0, 0); }
        float alpha[4];
#pragma unroll
        for (int j = 0; j < 4; ++j) { const int uq = 16 * w + (lane >> 4) * 4 + j; float mx = -1e30f;
#pragma unroll
            for (int kt = 0; kt < 8; ++kt) { const int uk = 16 * kt + (lane & 15); const int df = (uq - uk) * dsgn; const unsigned mk = (unsigned)(df >> 31);
                const float v = __uint_as_float((__float_as_uint(s[kt][j]) & ~mk) | (0xF149F2CAu & mk)); s[kt][j] = v; mx = fmaxf(mx, v); }
            mx = fmaxf(mx, SHX(mx, 1)); mx = fmaxf(mx, SHX(mx, 2)); mx = fmaxf(mx, SHX(mx, 4)); mx = fmaxf(mx, SHX(mx, 8));
            const float mn = fmaxf(mrow[j], mx); alpha[j] = __expf(mrow[j] - mn); mrow[j] = mn; float rs = 0.f;
#pragma unroll
            for (int kt = 0; kt < 8; ++kt) { const float pv = __expf(s[kt][j] - mn); s[kt][j] = pv; rs += pv; }
            rs += SHX(rs, 1); rs += SHX(rs, 2); rs += SHX(rs, 4); rs += SHX(rs, 8);
            lrow[j] = lrow[j] * alpha[j] + rs; }
#pragma unroll
        for (int dt = 0; dt < 8; ++dt)
#pragma unroll
            for (int j = 0; j < 4; ++j) o[dt][j] *= alpha[j];
#pragma unroll
        for (int kt = 0; kt < 8; ++kt)
#pragma unroll
            for (int j = 0; j < 4; ++j) PW[((lane >> 4) * 4 + j) * 136 + 16 * kt + (lane & 15)] = f2bf(s[kt][j]);
        __builtin_amdgcn_wave_barrier();
#pragma unroll
        for (int ks = 0; ks < 4; ++ks) { const bf16x8 pf = frag_ld(PW, 136, 0, 32 * ks, lane); bf16x8 vf[8];
#pragma unroll
            for (int dt = 0; dt < 8; ++dt) vf[dt] = frag_ld(VT, 136, 16 * dt, 32 * ks, lane);
            __builtin_amdgcn_sched_barrier(0);
#pragma unroll
            for (int dt = 0; dt < 8; ++dt) o[dt] = __builtin_amdgcn_mfma_f32_16x16x32_bf16(pf, vf[dt], o[dt], 0, 0, 0); }
        if (last) {
#pragma unroll
            for (int j = 0; j < 4; ++j) { const float il = 1.f / lrow[j];
#pragma unroll
                for (int dt = 0; dt < 8; ++dt) PW[((lane >> 4) * 4 + j) * 136 + 16 * dt + (lane & 15)] = f2bf(o[dt][j] * il);
                if ((lane & 15) == 0) { const int uq = 128 * cur.qb + 16 * w + (lane >> 4) * 4 + j; LSE[((size_t)cur.g * MP + (size_t)(cur.rowbase + cur.rate * uq)) * 8 + cur.h] = mrow[j] + __logf(lrow[j]); } }
            __builtin_amdgcn_wave_barrier();
#pragma unroll
            for (int i = 0; i < 4; ++i) { const int q = lane + 64 * i, r = q >> 4, ch = q & 15; const size_t row = (size_t)(cur.rowbase + cur.rate * (128 * cur.qb + 16 * w + r));
                *(u32x4*)(OP + ((size_t)cur.g * MP + row) * 1024 + cur.h * 128 + ch * 8) = *(const u32x4*)(PW + r * 136 + ch * 8); }
        }
        __syncthreads();
        cur = nxt;
    }
#undef ATT_PREFETCH
#undef ATT_QPREFETCH
}
__device__ void attn_sample_item(CParams& p, unsigned char* smem, int bs, int h) {
    const int tid = get_tid(), lane = tid & 63, w = __builtin_amdgcn_readfirstlane(tid >> 6);
    float* QS = (float*)smem; float* SC = QS + 384; float* RED = SC + 400; float* PART = RED + 16;
    const bf16_t* QB = (const bf16_t*)(p.ws + B_QB); bf16_t* ATT = (bf16_t*)(p.ws + B_ATT);
    const size_t row = MP + bs;
    if (tid < 384) QS[tid] = bf2f(QB[row * 3072 + ((tid >> 7) * 8 + h) * 128 + (tid & 127)]);
    __syncthreads();
    const int quad = tid & 31, kq = tid >> 5;
    const float* knew = p.out + O_SK + ((size_t)bs * 8 + h) * 128; const float* vnew = p.out + O_SV + ((size_t)bs * 8 + h) * 128;
#pragma unroll 5
    for (int ch = 0; ch < 25; ++ch) { const int pi = ch * 16 + kq; const int pc = pi < 387 ? pi : 386; const int g = pc / 129, j = pc - g * 129; const int rate = g == 0 ? 1 : (g == 1 ? 4 : 16);
        const float* kp = j == 0 ? knew : p.in[4] + (((size_t)bs * 2048 + (2048 - j * rate)) * 8 + h) * 128;
        const f32x4 kv = *(const f32x4*)(kp + 4 * quad), qv = *(const f32x4*)(QS + g * 128 + 4 * quad);
        float d = kv[0] * qv[0] + kv[1] * qv[1] + kv[2] * qv[2] + kv[3] * qv[3];
        d += SHX(d, 16); d += SHX(d, 8); d += SHX(d, 4); d += SHX(d, 2); d += SHX(d, 1);
        if (quad == 0 && pi < 387) SC[pi] = d; }
    __syncthreads();
    float sv = tid < 387 ? SC[tid] : -1e30f; float mx = wave_max(sv, lane); if (lane == 0) RED[w] = mx;
    __syncthreads();
    mx = RED[0];
#pragma unroll
    for (int i = 1; i < 8; ++i) mx = fmaxf(mx, RED[i]);
    const float pv = tid < 387 ? __expf(sv - mx) : 0.f; const float ps = wave_sum(pv, lane);
    __syncthreads();
    if (tid < 387) SC[tid] = pv; if (lane == 0) RED[8 + w] = ps;
    __syncthreads();
    float tot = 0.f;
#pragma unroll
    for (int i = 0; i < 8; ++i) tot += RED[8 + i];
    { f32x4 acc = zero4();
#pragma unroll 5
      for (int ch = 0; ch < 25; ++ch) { const int pi = ch * 16 + kq; const int pc = pi < 387 ? pi : 386; const int g = pc / 129, j = pc - g * 129; const int rate = g == 0 ? 1 : (g == 1 ? 4 : 16);
          const float* vp = j == 0 ? vnew : p.in[5] + (((size_t)bs * 2048 + (2048 - j * rate)) * 8 + h) * 128;
          const f32x4 vv = *(const f32x4*)(vp + 4 * quad); const float pw = pi < 387 ? SC[pc] : 0.f; acc = acc + vv * pw; }
      *(f32x4*)(PART + kq * 128 + 4 * quad) = acc; }
    __syncthreads();
    if (tid < 128) { float o = 0.f;
#pragma unroll
        for (int k = 0; k < 16; ++k) o += PART[k * 128 + tid];
        ATT[row * 1024 + h * 128 + tid] = f2bf(o / tot); }
    __syncthreads();
}
__device__ void phase_attn(CParams& p, unsigned char* smem) {
    attn_prompt(p, smem);
    for (int it = get_bid(); it < 64; it += gridDim.x) attn_sample_item(p, smem, it >> 3, it & 7);
}
__device__ void phase_combine(CParams& p) {
    const bf16_t* OP = (const bf16_t*)(p.ws + B_OP); const float* LSE = (const float*)(p.ws + B_LSE); bf16_t* ATT = (bf16_t*)(p.ws + B_ATT);
    const int stride = gridDim.x * NTHR;
    for (int i0 = get_bid() * NTHR + get_tid(); i0 < MP * 128; i0 += 4 * stride) {
        float l[4][3]; u32x4 v[4][3]; bool ok[4];
#pragma unroll
        for (int k = 0; k < 4; ++k) { const int i = i0 + k * stride; ok[k] = i < MP * 128; const int ii = ok[k] ? i : i0; const int row = ii >> 7, c8 = (ii & 127) * 8, h = c8 >> 7;
#pragma unroll
            for (int g = 0; g < 3; ++g) { l[k][g] = LSE[((size_t)g * MP + row) * 8 + h]; v[k][g] = *(const u32x4*)(OP + ((size_t)g * MP + row) * 1024 + c8); } }
#pragma unroll
        for (int k = 0; k < 4; ++k) { const int i = i0 + k * stride; if (!ok[k]) continue; const int row = i >> 7, c8 = (i & 127) * 8;
            const float mx = fmaxf(l[k][0], fmaxf(l[k][1], l[k][2])); float w0 = __expf(l[k][0] - mx), w1 = __expf(l[k][1] - mx), w2 = __expf(l[k][2] - mx); const float inv = __builtin_amdgcn_rcpf(w0 + w1 + w2); w0 *= inv; w1 *= inv; w2 *= inv;
            u32x4 o;
#pragma unroll
            for (int e = 0; e < 4; ++e) o[e] = pk2(w0 * bf2f(v[k][0][e] & 0xffffu) + w1 * bf2f(v[k][1][e] & 0xffffu) + w2 * bf2f(v[k][2][e] & 0xffffu), w0 * bf2f(v[k][0][e] >> 16) + w1 * bf2f(v[k][1][e] >> 16) + w2 * bf2f(v[k][2][e] >> 16));
            *(u32x4*)(ATT + (size_t)row * 1024 + c8) = o; }
    }
}

#ifndef PROGRAM
#define PROGRAM 0,1,2,3,4,5,6,7,8,9,10,11,12,13,14,15,16,17,18
#endif
__constant__ const int PROG[] = {PROGRAM};
constexpr int NPHASE = sizeof(PROG) / sizeof(int);
#ifndef PHMASK
#define PHMASK 0xFFFFFFFFu
#endif
#define PHON(x) ((PHMASK >> (x)) & 1u)
__global__ __launch_bounds__(512, 2) void yoco_fwd(Params p_unused, int ph_lo, int ph_hi) {
    extern __shared__ __attribute__((aligned(16))) unsigned char smem[];
    volatile LAS unsigned* xst = (volatile LAS unsigned*)(smem + 131072);
    if (threadIdx.x == 0) { xst[0] = 0u; xst[1] = 0u; }
    __syncthreads();
    XcdBarrier xb = xcd_barrier_post((unsigned*)(((CParams*)__builtin_amdgcn_kernarg_segment_ptr())->ws + B_BAR), xst);
    for (int pi = ph_lo; pi < ph_hi; ++pi) {
        const int ph = PROG[pi];
        CParams* pp = (CParams*)__builtin_amdgcn_kernarg_segment_ptr(); asm volatile("" : "+s"(pp));
        CParams& p = *pp; unsigned char* ws = p.ws;
        const bf16_t* XN = (const bf16_t*)(ws + B_XN); const bf16_t* ZX = (const bf16_t*)(ws + B_ZX); const bf16_t* H = (const bf16_t*)(ws + B_H);
        int gk = -1, lda = DM, N = 2048, K = 2048; const bf16_t* A = XN; size_t wo = 0;
        switch (ph) {
#if PHON(0)
        case 0: phase_convert(p, smem); phase_rmsnorm<0>(p); break;
#endif
        case 1: gk = 0; wo = W_IN; N = INP_PAD; break;
#if PHON(2)
        case 2: phase_ssd_states(p, smem); break;
#endif
#if PHON(3)
        case 3: phase_scan(p); break;
#endif
#if PHON(4)
        case 4: phase_ssd_out(p, smem); break;
#endif
#if PHON(5)
        case 5: phase_gnorm(p); break;
#endif
        case 6: gk = 1; A = ZX; lda = ZLD; wo = W_OUT; K = 4096; break;
#if PHON(7)
        case 7: case 10: case 15: phase_rmsnorm<1>(p); break;
#endif
        case 8: gk = 2; wo = W_GU0; N = 11264; break;
        case 9: gk = 1; A = H; lda = FF; wo = W_DN0; K = FF; break;
        case 11: gk = 3; wo = W_KVQ; N = 5120; break;
#if PHON(12)
        case 12: phase_attn(p, smem); break;
#endif
#if PHON(13)
        case 13: phase_combine(p); break;
#endif
        case 14: gk = 1; A = (const bf16_t*)(ws + B_ATT); lda = 1024; wo = W_O; K = 1024; break;
        case 16: gk = 2; wo = W_GU1; N = 11264; break;
        case 17: gk = 1; A = H; lda = FF; wo = W_DN1; K = FF; break;
#if PHON(18)
        case 18: phase_rmsnorm<2>(p); break;
#endif
        default: break;
        }
#if PHON(1)
        if (gk >= 0) { const bool first_res = (ph == 6); const float* XRc = (const float*)(ws + B_XR);
            EpiAll E{gk, ws, p.out, first_res ? p.in[0] : XRc}; run_gemm(smem, A, lda, (const bf16_t*)(ws + wo), N, K, E);
            thin_gemm(p, smem, A, lda, (const bf16_t*)(ws + wo), N, K, gk, first_res ? p.in[1] : XRc + (size_t)MP * 2048);
 }
        {
            const int bid = get_bid(); const bool g256 = gridDim.x == 256; int t0 = -1, ts = 1, te = 0;
            if (ph == 0) { t0 = bid; ts = gridDim.x; te = g256 ? 3936 : 6816; }
            else if (ph == 1 && g256 && bid >= 32) { t0 = 3936 + (bid - 32); ts = 224; te = 5280; }
            else if (ph == 8 && g256 && bid >= 128) { t0 = 5280 + (bid - 128); ts = 128; te = 6048; }
            else if (ph == 11 && g256 && bid >= 128) { t0 = 6048 + (bid - 128); ts = 128; te = 6816; }
            if (t0 >= 0) convert_tiles(p, smem, t0, ts, te); }
#endif
        if (pi + 1 < ph_hi) { if (pi == ph_lo) { __syncthreads(); cg::this_grid().sync(); } else xcd_barrier(xb); }
    }
}

#ifndef MULTI_LAUNCH
#define MULTI_LAUNCH 0
#endif
extern "C" void kernel_launch(void* const* d_in, const int* in_sizes, int n_in, void* d_out, int out_size, void* d_ws, size_t ws_size, hipStream_t stream) {
    static int grid = 0;
    if (grid == 0) {
        if (ws_size < WS_NEED) { fprintf(stderr, "kernel_launch: workspace too small: %zu < %zu\n", ws_size, (size_t)WS_NEED); grid = -1; return; }
        if (hipFuncSetAttribute((const void*)yoco_fwd, hipFuncAttributeMaxDynamicSharedMemorySize, LDS_BYTES) != hipSuccess) { fprintf(stderr, "kernel_launch: hipFuncSetAttribute failed\n"); grid = -1; return; }
        int dev = 0, cus = 0, per_cu = 0;
        (void)hipGetDevice(&dev); (void)hipDeviceGetAttribute(&cus, hipDeviceAttributeMultiprocessorCount, dev);
        (void)hipOccupancyMaxActiveBlocksPerMultiprocessor(&per_cu, (const void*)yoco_fwd, NTHR, LDS_BYTES);
        if (per_cu < 1) { fprintf(stderr, "kernel_launch: occupancy query says %d blocks per CU\n", per_cu); per_cu = 1; }
        grid = cus;
        (void)hipGetLastError();
    }
    if (grid < 0) return;
    if (hipMemsetAsync((unsigned char*)d_ws + B_BAR, 0, 3456 * 4, stream) != hipSuccess) { fprintf(stderr, "kernel_launch: memset of barrier words failed\n"); return; }
    Params p{};
    for (int i = 0; i < 24; ++i) p.in[i] = (const float*)d_in[i];
    p.out = (float*)d_out; p.ws = (unsigned char*)d_ws;
#if MULTI_LAUNCH
    for (int ph = 0; ph < NPHASE; ++ph) hipLaunchKernelGGL(yoco_fwd, dim3(grid), dim3(NTHR), LDS_BYTES, stream, p, ph, ph + 1);
#else
    int lo = 0, hi = NPHASE; void* args[] = {&p, &lo, &hi};
    hipError_t e = hipLaunchCooperativeKernel((const void*)yoco_fwd, dim3(grid), dim3(NTHR), args, LDS_BYTES, stream);
    if (e != hipSuccess) fprintf(stderr, "cooperative launch failed: %s (grid %d)\n", hipGetErrorString(e), grid);
#endif
}
```

```cpp
#include <hip/hip_runtime.h>
#include <hip/hip_cooperative_groups.h>
#include <cstdio>
namespace cg = cooperative_groups;

#define LAS __attribute__((address_space(3)))
typedef unsigned short bf16_t;
typedef short bf16x8 __attribute__((ext_vector_type(8)));
typedef float f32x4 __attribute__((ext_vector_type(4)));
typedef float f32x2 __attribute__((ext_vector_type(2)));
typedef unsigned u32x4 __attribute__((ext_vector_type(4)));
typedef unsigned u32x2 __attribute__((ext_vector_type(2)));

constexpr int DM = 2048, SEQ = 4096, MP = 8192, NS = 8, MV = 8200, MPAD = 8448;
constexpr int DIN = 4096, CONVD = 6144, INP_PAD = 10496, ZLD = 10496;
constexpr int FF = 5632;
constexpr float EPS = 1e-6f;
constexpr int NTHR = 512;
constexpr int LDS_BYTES = 131072 + 16;

constexpr size_t O_YP = 0, O_PCONV = 16793600, O_PSSM = 16830464, O_PK = 17879040, O_PV = 22073344,
                 O_SCONV = 26267648, O_SSSM = 26415104, O_SK = 30609408, O_SV = 30617600;

constexpr size_t al256(size_t x) { return (x + 255) & ~(size_t)255; }
constexpr size_t W_IN = 0;
constexpr size_t W_OUT = W_IN + (size_t)INP_PAD * 2048 * 2;
constexpr size_t W_GU0 = W_OUT + (size_t)2048 * 4096 * 2;
constexpr size_t W_DN0 = W_GU0 + (size_t)11264 * 2048 * 2;
constexpr size_t W_KVQ = W_DN0 + (size_t)2048 * 5632 * 2;
constexpr size_t W_O = W_KVQ + (size_t)5120 * 2048 * 2;
constexpr size_t W_GU1 = W_O + (size_t)2048 * 1024 * 2;
constexpr size_t W_DN1 = W_GU1 + (size_t)11264 * 2048 * 2;
constexpr size_t T_COS = W_DN1 + (size_t)2048 * 5632 * 2;
constexpr size_t T_SIN = T_COS + al256((size_t)4097 * 64 * 4);
constexpr size_t B_XR = T_SIN + al256((size_t)4097 * 64 * 4);
constexpr size_t B_XN = B_XR + (size_t)MPAD * 2048 * 4;
constexpr size_t B_DT = B_XN + (size_t)MPAD * 2048 * 2;
constexpr size_t B_CD = B_DT + (size_t)MPAD * 64 * 4;
constexpr size_t B_GS = B_CD + al256((size_t)2 * 32 * 64 * 4);
constexpr size_t B_BAR = B_GS + al256((size_t)MPAD * 8 * 4);
constexpr size_t B_R = B_BAR + al256((size_t)3456 * 4);
constexpr size_t B_ZX = B_R;
constexpr size_t B_ST = B_ZX + (size_t)MPAD * ZLD * 2;
constexpr size_t B_HPV = B_ST + (size_t)2 * 32 * 64 * 64 * 128 * 2;
constexpr size_t R_END1 = B_HPV + (size_t)2 * 32 * 64 * 64 * 128 * 2;
constexpr size_t B_H = B_R;
constexpr size_t B_KB = B_H + (size_t)MPAD * FF * 2;
constexpr size_t B_VB = B_KB + (size_t)MPAD * 1024 * 2;
constexpr size_t B_QB = B_VB + (size_t)MPAD * 1024 * 2;
constexpr size_t B_OP = B_QB + (size_t)MPAD * 3072 * 2;
constexpr size_t B_LSE = B_OP + (size_t)3 * MP * 1024 * 2;
constexpr size_t B_ATT = B_LSE + al256((size_t)3 * MP * 8 * 4);
constexpr size_t R_END2 = B_ATT + (size_t)MPAD * 1024 * 2;
constexpr size_t WS_NEED = R_END1 > R_END2 ? R_END1 : R_END2;

struct Params {
    const float* in[24];
    float* out;
    unsigned char* ws;
};
typedef const __attribute__((address_space(4))) Params CParams;
__device__ __forceinline__ float __attribute__((ext_vector_type(4))) zero4() { float z = 0.f; asm volatile("" : "+v"(z)); float __attribute__((ext_vector_type(4))) r = {z, z, z, z}; return r; }
__device__ __forceinline__ int get_bid() { int b = blockIdx.x; asm volatile("" : "+s"(b)); return b; }
__device__ __forceinline__ int get_tid() { int t = threadIdx.x; asm volatile("" : "+v"(t)); return t; }

__device__ __forceinline__ float bf2f(unsigned v) { return __uint_as_float(v << 16); }
typedef __bf16 bf16x2_t __attribute__((ext_vector_type(2)));
__device__ __forceinline__ unsigned pk2(float lo, float hi) { f32x2 v = {lo, hi}; bf16x2_t b = __builtin_convertvector(v, bf16x2_t); return __builtin_bit_cast(unsigned, b); }
__device__ __forceinline__ bf16_t f2bf(float v) { return (bf16_t)(pk2(v, 0.f) & 0xffffu); }
__device__ __forceinline__ float silu_f(float v) { return v * __builtin_amdgcn_rcpf(1.f + __expf(-v)); }
__device__ __forceinline__ float softplus_f(float x) { return x > 20.f ? x : log1pf(__expf(x)); }
__device__ __forceinline__ float shl(float v, int src) { return __int_as_float(__builtin_amdgcn_ds_bpermute(src << 2, __float_as_int(v))); }
#define SHX(v, o) shl((v), lane ^ (o))
__device__ __forceinline__ float wave_sum(float v, int lane) { for (int o = 32; o >= 1; o >>= 1) v += SHX(v, o); return v; }
__device__ __forceinline__ float wave_max(float v, int lane) { for (int o = 32; o >= 1; o >>= 1) v = fmaxf(v, SHX(v, o)); return v; }
__device__ __forceinline__ bf16x8 frag_ld(const bf16_t* base, int ld, int row0, int k0, int lane) {
    return *(const bf16x8*)(base + (row0 + (lane & 15)) * ld + k0 + (lane >> 4) * 8);
}


#define XB_TMO      128
#define XB_XCNT(j)  (256  + 64 * (j))
#define XB_XSUB(j)  (1280 + 64 * (j))
#define XB_XGEN(j)  (2304 + 64 * (j))
#define XB_TOP      3328
#define XB_TOPGEN   3392
#define XCD_BAR_WORDS 3456
#define XB_SPIN_CAP (1u << 18)
__device__ __forceinline__ unsigned xb_ld(unsigned* p)              { return __hip_atomic_load(p, __ATOMIC_RELAXED, __HIP_MEMORY_SCOPE_AGENT); }
__device__ __forceinline__ unsigned xb_add(unsigned* p, unsigned v) { return __hip_atomic_fetch_add(p, v, __ATOMIC_RELAXED, __HIP_MEMORY_SCOPE_AGENT); }
__device__ __forceinline__ unsigned xb_xcc_id() { return (unsigned)__builtin_amdgcn_s_getreg((3 << 11) | 20) & 0xFu; }
#define XB_SPIN(cond, bar) do { unsigned _sp = 0; while (cond) { __builtin_amdgcn_s_sleep(1); \
    if ((++_sp & 255u) == 0u) { if (xb_ld(&(bar)[XB_TMO])) break; if (_sp > XB_SPIN_CAP) { atomicAdd(&(bar)[XB_TMO], 1u); break; } } } } while (0)
struct XcdBarrier { unsigned* bar; unsigned x; volatile LAS unsigned* st; };
__device__ __forceinline__ XcdBarrier xcd_barrier_post(unsigned* bar, volatile LAS unsigned* st) {
    XcdBarrier b; b.bar = bar; b.x = xb_xcc_id(); b.st = st;
    if (threadIdx.x == 0) (void)xb_add(&bar[XB_XCNT(b.x)], 1u);
    return b;
}
__device__ __forceinline__ void xcd_barrier_complete(unsigned* bar, unsigned x, unsigned& nloc, unsigned& nx) {
    const unsigned G = gridDim.x * gridDim.y * gridDim.z;
    unsigned sum, cnt, mine, sp = 0u;
    for (;;) {
        sum = 0u; cnt = 0u; mine = 0u;
#pragma unroll
        for (unsigned j = 0; j < 16; ++j) { const unsigned c = xb_ld(&bar[XB_XCNT(j)]); sum += c; cnt += (c > 0u) ? 1u : 0u; mine = (j == x) ? c : mine; }
        if (sum == G) break;
        __builtin_amdgcn_s_sleep(1);
        if ((++sp & 255u) == 0u) { if (xb_ld(&bar[XB_TMO])) break; if (sp > XB_SPIN_CAP) { atomicAdd(&bar[XB_TMO], 1u); break; } }
    }
    nloc = mine > 0u ? mine : 1u; nx = cnt > 0u ? cnt : 1u;
}
__device__ __forceinline__ void xcd_barrier(const XcdBarrier& b) {
    asm volatile("s_waitcnt vmcnt(0)" ::: "memory");
    __syncthreads();
    if (threadIdx.x == 0) {
        unsigned* bar = b.bar;
        __builtin_amdgcn_s_waitcnt(0);
        unsigned nloc = b.st[0], nx = b.st[1];
        if (nloc == 0u) { xcd_barrier_complete(bar, b.x, nloc, nx); b.st[0] = nloc; b.st[1] = nx; }
        const unsigned old = xb_add(&bar[XB_XSUB(b.x)], 1u);
        const unsigned gen = old / nloc;
        if (old + 1u == (gen + 1u) * nloc) {
            __builtin_amdgcn_fence(__ATOMIC_RELEASE, "agent");
            asm volatile("s_waitcnt vmcnt(0)" ::: "memory");
            const unsigned og = xb_add(&bar[XB_TOP], 1u);
            const unsigned tg = og / nx;
            if (og + 1u == (tg + 1u) * nx) xb_add(&bar[XB_TOPGEN], 1u);
            else XB_SPIN(xb_ld(&bar[XB_TOPGEN]) == tg, bar);
            __builtin_amdgcn_fence(__ATOMIC_ACQUIRE, "agent");
            xb_add(&bar[XB_XGEN(b.x)], 1u);
            asm volatile("s_waitcnt vmcnt(0)" ::: "memory");
        } else {
            XB_SPIN(xb_ld(&bar[XB_XGEN(b.x)]) == gen, bar);
            __builtin_amdgcn_fence(__ATOMIC_ACQUIRE, "agent");
            asm volatile("s_waitcnt vmcnt(0)" ::: "memory");
        }
    }
    __syncthreads();
}

namespace pg8 {
constexpr int BM = 256, BK = 64, HALF = 128, HTB = HALF * BK * 2, NXCD = 8, WGM = 8;
__device__ __forceinline__ int lds_byte(int r, int c) { const int st = (r >> 4) * 2 + (c >> 5), rr = r & 15, cc = c & 31, ob = rr * 64 + cc * 2; return st * 1024 + (ob ^ (((ob >> 9) & 1) << 5)); }
__device__ __forceinline__ void stage_rc(int b, int& R, int& C) { const int st = b / 1024, sb = b % 1024, swz = sb ^ (((sb >> 9) & 1) << 5); R = (st >> 1) * 16 + swz / 64; C = (st & 1) * 32 + (swz % 64) / 2; }
__device__ __forceinline__ int perm32(int rho) { const int n = rho >> 4, i = rho & 15; return 8 * (i >> 2) + 4 * n + (i & 3); }
struct Unit { int pm, pn; };
struct Gemm { const bf16_t* A; const bf16_t* Bt; int M, N, K, lda; };
struct StaticOrder {
    int nM, nN, nwg, G, c;
    __device__ void init(int M, int N, int G_, int c_) { nM = M / BM; nN = N / BM; nwg = nM * nN; G = G_; c = c_; }
    __device__ bool next(int i, Unit& u) const {
        const long L = (long)i * G + c; if (L >= nwg) return false;
        int wgid = (int)L; { const int q = nwg / NXCD, r = nwg % NXCD, xcd = wgid % NXCD, off = wgid / NXCD; wgid = (xcd < r ? xcd * (q + 1) : r * (q + 1) + (xcd - r) * q) + off; }
        const int nig = WGM * nN, gid = wgid / nig, fm = gid * WGM, gsz = (nM - fm) < WGM ? (nM - fm) : WGM;
        u.pm = fm + ((wgid % nig) % gsz); u.pn = (wgid % nig) / gsz; return true;
    }
};

template <class Epi>
__device__ __forceinline__ void gemm_phase(LAS unsigned char* lds, const Gemm g, const StaticOrder& S, const Epi& E) {
    const int tid = get_tid(), wid = __builtin_amdgcn_readfirstlane(tid >> 6), lane = tid & 63, wr = wid >> 2, wc = wid & 3, fr = lane & 15, fq = lane >> 4;
    const int K = g.K, nt = K / BK, lda = g.lda;
    unsigned voffA[2], voffB[2];
#pragma unroll
    for (int i = 0; i < 2; ++i) { int R, C; stage_rc(tid * 16 + i * 8192, R, C); const int Rb = (R & ~31) + perm32(R & 31);
        voffA[i] = (unsigned)(R * lda + C) * 2u; voffB[i] = (unsigned)(Rb * K + C) * 2u; }
    const size_t kstep = (size_t)(BK * 2);
    const size_t hstepA = (size_t)HALF * lda * 2, hstepB = (size_t)HALF * K * 2;
    const size_t tstepA = 2 * hstepA, tstepB = 2 * hstepB;
    const unsigned ldsw = (unsigned)wid * 1024u;
    const int aoff = lds_byte(wr * 64 + fr, fq * 8), boff = lds_byte(wc * 32 + fr, fq * 8);
#define PG8_SA(b, h) (((b) * 2 + (h)) * HTB)
#define PG8_SB(b, h) ((4 + (b) * 2 + (h)) * HTB)
#define PG8_STAGE(bufoff, gbase, voff) do { _Pragma("unroll") for (int _i = 0; _i < 2; ++_i) \
        __builtin_amdgcn_global_load_lds((const unsigned*)((const char*)(gbase) + (voff)[_i]), (LAS unsigned*)(lds + (bufoff) + ldsw + _i * 8192), 16, 0, 0); } while (0)
#define PG8_LDA(dst, b, h) do { _Pragma("unroll") for (int m = 0; m < 4; ++m) _Pragma("unroll") for (int k = 0; k < 2; ++k) dst[m][k] = *(const LAS bf16x8*)(lds + PG8_SA(b, h) + aoff + m * 2048 + k * 1024); } while (0)
#define PG8_LDB(dst, b, h) do { _Pragma("unroll") for (int n = 0; n < 2; ++n) _Pragma("unroll") for (int k = 0; k < 2; ++k) dst[n][k] = *(const LAS bf16x8*)(lds + PG8_SB(b, h) + boff + n * 2048 + k * 1024); } while (0)
#define PG8_MMA(ai, bj, At, Bt) do { __builtin_amdgcn_s_setprio(1); _Pragma("unroll") for (int m = 0; m < 4; ++m) _Pragma("unroll") for (int n = 0; n < 2; ++n) _Pragma("unroll") for (int k = 0; k < 2; ++k) \
        acc[ai][bj][m][n] = __builtin_amdgcn_mfma_f32_16x16x32_bf16(Bt[n][k], At[m][k], acc[ai][bj][m][n], 0, 0, 0); __builtin_amdgcn_s_setprio(0); } while (0)
#define PG8_WAIT_V(n) asm volatile("s_waitcnt vmcnt(" #n ")" ::: "memory")
#define PG8_WAIT_L(n) asm volatile("s_waitcnt lgkmcnt(" #n ")" ::: "memory")
#define PG8_BAR __builtin_amdgcn_s_barrier()
#define PG8_SCHED __builtin_amdgcn_sched_barrier(0)
    Unit cur, nxt; int ui = 0;
    if (!S.next(0, cur)) return;
    f32x4 acc[2][2][4][2];
#pragma unroll
    for (int a = 0; a < 2; ++a)
#pragma unroll
        for (int b = 0; b < 2; ++b)
#pragma unroll
            for (int m = 0; m < 4; ++m)
#pragma unroll
                for (int n = 0; n < 2; ++n) acc[a][b][m][n] = zero4();
    bf16x8 At[4][2], B0[2][2], B1[2][2];
    const char* cA = (const char*)g.A + (size_t)cur.pm * tstepA; const char* cB = (const char*)g.Bt + (size_t)cur.pn * tstepB;
    PG8_STAGE(PG8_SB(0, 0), cB, voffB); PG8_STAGE(PG8_SA(0, 0), cA, voffA); PG8_STAGE(PG8_SB(0, 1), cB + hstepB, voffB); PG8_STAGE(PG8_SA(0, 1), cA + hstepA, voffA);
    if (wr == 1) PG8_BAR;
    PG8_WAIT_V(4); PG8_BAR;
    PG8_STAGE(PG8_SB(1, 0), cB + kstep, voffB); PG8_STAGE(PG8_SA(1, 0), cA + kstep, voffA); PG8_STAGE(PG8_SB(1, 1), cB + hstepB + kstep, voffB);
    PG8_WAIT_V(6); PG8_BAR;
    for (;;) {
        const bool has_next = S.next(ui + 1, nxt);
        const char* nA = has_next ? (const char*)g.A + (size_t)nxt.pm * tstepA : cA; const char* nB = has_next ? (const char*)g.Bt + (size_t)nxt.pn * tstepB : cB;
        for (int t = 0; t < nt; t += 2) {
            const bool last = (t == nt - 2);
            const char* a1 = cA + (size_t)(t + 1) * kstep;
            const char* a2 = last ? nA : cA + (size_t)(t + 2) * kstep; const char* b2 = last ? nB : cB + (size_t)(t + 2) * kstep;
            const char* a3 = a2 + kstep; const char* b3 = b2 + kstep;
            PG8_LDB(B0, 0, 0); PG8_SCHED; PG8_LDA(At, 0, 0); PG8_STAGE(PG8_SA(1, 1), a1 + hstepA, voffA);
            PG8_WAIT_L(8); PG8_BAR; PG8_WAIT_L(0); PG8_MMA(0, 0, At, B0); PG8_BAR; PG8_SCHED;
            PG8_LDB(B1, 0, 1); PG8_STAGE(PG8_SB(0, 0), b2, voffB);
            PG8_BAR; PG8_WAIT_L(0); PG8_MMA(0, 1, At, B1); PG8_BAR;
            PG8_LDA(At, 0, 1); PG8_STAGE(PG8_SA(0, 0), a2, voffA);
            PG8_BAR; PG8_WAIT_L(0); PG8_MMA(1, 0, At, B0); PG8_BAR; PG8_SCHED;
            PG8_STAGE(PG8_SB(0, 1), b2 + hstepB, voffB);
            PG8_WAIT_V(6); PG8_BAR; PG8_MMA(1, 1, At, B1); PG8_BAR;
            PG8_LDB(B0, 1, 0); PG8_SCHED; PG8_LDA(At, 1, 0); PG8_STAGE(PG8_SA(0, 1), a2 + hstepA, voffA);
            PG8_WAIT_L(8); PG8_BAR; PG8_WAIT_L(0); PG8_MMA(0, 0, At, B0); PG8_BAR; PG8_SCHED;
            PG8_LDB(B1, 1, 1); PG8_STAGE(PG8_SB(1, 0), b3, voffB);
            PG8_BAR; PG8_WAIT_L(0); PG8_MMA(0, 1, At, B1); PG8_BAR;
            PG8_LDA(At, 1, 1); PG8_STAGE(PG8_SA(1, 0), a3, voffA);
            PG8_BAR; PG8_WAIT_L(0); PG8_MMA(1, 0, At, B0); PG8_BAR; PG8_SCHED;
            PG8_STAGE(PG8_SB(1, 1), b3 + hstepB, voffB);
            PG8_WAIT_V(6); PG8_BAR; PG8_MMA(1, 1, At, B1); PG8_BAR;
        }
        E(acc, cur, wr, wc, fr, fq);
        if (!has_next) break;
#pragma unroll
        for (int a = 0; a < 2; ++a)
#pragma unroll
            for (int b = 0; b < 2; ++b)
#pragma unroll
                for (int m = 0; m < 4; ++m)
#pragma unroll
                    for (int n = 0; n < 2; ++n) acc[a][b][m][n] = zero4();
        cur = nxt; cA = nA; cB = nB; ++ui;
    }
    PG8_WAIT_V(0);
    if (wr == 0) PG8_BAR;
    PG8_BAR;
#undef PG8_SA
#undef PG8_SB
#undef PG8_STAGE
#undef PG8_LDA
#undef PG8_LDB
#undef PG8_MMA
}
}
using pg8::Unit;
typedef f32x4 AccT[2][2][4][2];

__device__ __forceinline__ void epi_inproj(bf16_t* ZX, float* DT, const AccT& acc, const Unit& u, int wr, int wc, int fr, int fq) {
        const int row0 = u.pm * 256 + wr * 64 + fr;
        if (u.pn < 40) {
#pragma unroll
            for (int ai = 0; ai < 2; ++ai)
#pragma unroll
                for (int m = 0; m < 4; ++m) { __builtin_amdgcn_sched_barrier(0); __builtin_amdgcn_sched_barrier(0); bf16_t* rp = ZX + (size_t)(row0 + ai * 128 + m * 16) * ZLD + u.pn * 256 + wc * 32 + 8 * fq;
#pragma unroll
                    for (int bj = 0; bj < 2; ++bj) { const f32x4 v0 = acc[ai][bj][m][0], v1 = acc[ai][bj][m][1];
                        *(u32x4*)(rp + bj * 128) = (u32x4){pk2(v0[0], v0[1]), pk2(v0[2], v0[3]), pk2(v1[0], v1[1]), pk2(v1[2], v1[3])}; } }
        } else if (wc < 2) {
#pragma unroll
            for (int ai = 0; ai < 2; ++ai)
#pragma unroll
                for (int m = 0; m < 4; ++m) { __builtin_amdgcn_sched_barrier(0); __builtin_amdgcn_sched_barrier(0); float* rp = DT + (size_t)(row0 + ai * 128 + m * 16) * 64 + wc * 32 + 8 * fq;
                    *(f32x4*)rp = acc[ai][0][m][0]; *(f32x4*)(rp + 4) = acc[ai][0][m][1]; }
        }
}
__device__ __forceinline__ void epi_resid(float* XR, const float* RS, const AccT& acc, const Unit& u, int wr, int wc, int fr, int fq) {
        const size_t ro0 = (size_t)(u.pm * 256 + wr * 64 + fr) * 2048 + u.pn * 256 + wc * 32 + 8 * fq;
        f32x4 rv[2][4];
#pragma unroll
        for (int q = 0; q < 4; ++q) rv[0][q] = *(const f32x4*)(RS + ro0 + (q >> 1) * 128 + 4 * (q & 1));
#pragma unroll
        for (int it = 0; it < 8; ++it) { const int ai = it >> 2, m = it & 3; const size_t ro = ro0 + (size_t)(ai * 128 + m * 16) * 2048;
            if (it < 7) { const size_t rn = ro0 + (size_t)(((it + 1) >> 2) * 128 + ((it + 1) & 3) * 16) * 2048;
#pragma unroll
                for (int q = 0; q < 4; ++q) rv[(it + 1) & 1][q] = *(const f32x4*)(RS + rn + (q >> 1) * 128 + 4 * (q & 1)); }
            __builtin_amdgcn_sched_barrier(0);
#pragma unroll
            for (int q = 0; q < 4; ++q) *(f32x4*)(XR + ro + (q >> 1) * 128 + 4 * (q & 1)) = rv[it & 1][q] + acc[ai][q >> 1][m][q & 1];
            __builtin_amdgcn_sched_barrier(0); }
}
__device__ __forceinline__ void epi_swiglu(bf16_t* H, const AccT& acc, const Unit& u, int wr, int wc, int fr, int fq) {
        const int row0 = u.pm * 256 + wr * 64 + fr;
#pragma unroll
        for (int ai = 0; ai < 2; ++ai)
#pragma unroll
            for (int m = 0; m < 4; ++m) { __builtin_amdgcn_sched_barrier(0); bf16_t* rp = H + (size_t)(row0 + ai * 128 + m * 16) * FF + u.pn * 128 + wc * 32 + 8 * fq;
                float h[8];
#pragma unroll
                for (int n = 0; n < 2; ++n)
#pragma unroll
                    for (int j = 0; j < 4; ++j) { const float gg = acc[ai][0][m][n][j], uu = acc[ai][1][m][n][j]; h[n * 4 + j] = silu_f(gg) * uu; }
                *(u32x4*)rp = (u32x4){pk2(h[0], h[1]), pk2(h[2], h[3]), pk2(h[4], h[5]), pk2(h[6], h[7])}; }
}
__device__ __forceinline__ void epi_kvq(bf16_t* KB, bf16_t* VB, bf16_t* QB, const float* COS, const float* SIN, float* out, const AccT& acc, const Unit& u, int wr, int wc, int fr, int fq) {
        const int row0 = u.pm * 256 + wr * 64 + fr;
        if (u.pn >= 4 && u.pn < 8) {
#pragma unroll
            for (int ai = 0; ai < 2; ++ai)
#pragma unroll
                for (int m = 0; m < 4; ++m) { __builtin_amdgcn_sched_barrier(0); __builtin_amdgcn_sched_barrier(0); const int row = row0 + ai * 128 + m * 16; const int colb = (u.pn - 4) * 256 + wc * 32 + 8 * fq;
                    float* op = nullptr;
                    if (row < MP) { const int t = row & 4095; if (t >= 2048) op = out + O_PV + ((size_t)(row >> 12) * 2048 + (t - 2048)) * 1024; }
                    else if (row < MV) op = out + O_SV + (size_t)(row - MP) * 1024;
#pragma unroll
                    for (int bj = 0; bj < 2; ++bj) { const f32x4 v0 = acc[ai][bj][m][0], v1 = acc[ai][bj][m][1]; const int col = colb + bj * 128;
                        *(u32x4*)(VB + (size_t)row * 1024 + col) = (u32x4){pk2(v0[0], v0[1]), pk2(v0[2], v0[3]), pk2(v1[0], v1[1]), pk2(v1[2], v1[3])};
                        if (op) { __builtin_nontemporal_store(v0, (f32x4*)(op + col)); __builtin_nontemporal_store(v1, (f32x4*)(op + col + 4)); } } }
        } else {
            const bool isk = u.pn < 4; const int head = (isk ? u.pn : u.pn - 8) * 2 + (wc >> 1); const int d0 = (wc & 1) * 32 + 8 * fq;
            f32x4 cs[2][4];
            { const int row = row0; const int pidx = row < MP ? (row & 4095) : 4096;
              cs[0][0] = *(const f32x4*)(COS + pidx * 64 + d0); cs[0][1] = *(const f32x4*)(COS + pidx * 64 + d0 + 4); cs[0][2] = *(const f32x4*)(SIN + pidx * 64 + d0); cs[0][3] = *(const f32x4*)(SIN + pidx * 64 + d0 + 4); }
#pragma unroll
            for (int it = 0; it < 8; ++it) { const int ai = it >> 2, m = it & 3; const int row = row0 + ai * 128 + m * 16;
                if (it < 7) { const int rown = row0 + ((it + 1) >> 2) * 128 + ((it + 1) & 3) * 16; const int pn_ = rown < MP ? (rown & 4095) : 4096;
                    cs[(it + 1) & 1][0] = *(const f32x4*)(COS + pn_ * 64 + d0); cs[(it + 1) & 1][1] = *(const f32x4*)(COS + pn_ * 64 + d0 + 4);
                    cs[(it + 1) & 1][2] = *(const f32x4*)(SIN + pn_ * 64 + d0); cs[(it + 1) & 1][3] = *(const f32x4*)(SIN + pn_ * 64 + d0 + 4); }
                __builtin_amdgcn_sched_barrier(0);
                const f32x4 c0 = cs[it & 1][0], c1 = cs[it & 1][1], s0 = cs[it & 1][2], s1 = cs[it & 1][3];
                const f32x4 x10 = acc[ai][0][m][0], x11 = acc[ai][0][m][1], x20 = acc[ai][1][m][0], x21 = acc[ai][1][m][1];
                const f32x4 a0 = x10 * c0 - x20 * s0, a1 = x11 * c1 - x21 * s1, b0 = x20 * c0 + x10 * s0, b1 = x21 * c1 + x11 * s1;
                const u32x4 pa = (u32x4){pk2(a0[0], a0[1]), pk2(a0[2], a0[3]), pk2(a1[0], a1[1]), pk2(a1[2], a1[3])};
                const u32x4 pb = (u32x4){pk2(b0[0], b0[1]), pk2(b0[2], b0[3]), pk2(b1[0], b1[1]), pk2(b1[2], b1[3])};
                if (isk) { bf16_t* kp = KB + (size_t)row * 1024 + head * 128 + d0; *(u32x4*)kp = pa; *(u32x4*)(kp + 64) = pb;
                    float* op = nullptr;
                    if (row < MP) { const int t = row & 4095; if (t >= 2048) op = out + O_PK + ((size_t)(row >> 12) * 2048 + (t - 2048)) * 1024; }
                    else if (row < MV) op = out + O_SK + (size_t)(row - MP) * 1024;
                    if (op) { float* q = op + head * 128 + d0; __builtin_nontemporal_store(a0, (f32x4*)q); __builtin_nontemporal_store(a1, (f32x4*)(q + 4)); __builtin_nontemporal_store(b0, (f32x4*)(q + 64)); __builtin_nontemporal_store(b1, (f32x4*)(q + 68)); }
                } else { bf16_t* qp = QB + (size_t)row * 3072 + head * 128 + d0; *(u32x4*)qp = pa; *(u32x4*)(qp + 64) = pb; }
                __builtin_amdgcn_sched_barrier(0); }
        }
}
struct EpiAll {
    int kind; unsigned char* ws; float* out; const float* rs;
    __device__ __forceinline__ void operator()(const AccT& acc, const Unit& u, int wr, int wc, int fr, int fq) const {
        if (kind == 0) epi_inproj((bf16_t*)(ws + B_ZX), (float*)(ws + B_DT), acc, u, wr, wc, fr, fq);
        else if (kind == 1) epi_resid((float*)(ws + B_XR), rs, acc, u, wr, wc, fr, fq);
        else if (kind == 2) epi_swiglu((bf16_t*)(ws + B_H), acc, u, wr, wc, fr, fq);
        else epi_kvq((bf16_t*)(ws + B_KB), (bf16_t*)(ws + B_VB), (bf16_t*)(ws + B_QB), (const float*)(ws + T_COS), (const float*)(ws + T_SIN), out, acc, u, wr, wc, fr, fq);
    }
};
template <class Epi>
__device__ __forceinline__ void run_gemm(unsigned char* smem, const bf16_t* A, int lda, const bf16_t* Bt, int N, int K, const Epi& E) {
    pg8::Gemm g; g.A = A; g.Bt = Bt; g.M = MP; g.N = N; g.K = K; g.lda = lda;
    pg8::StaticOrder S; S.init(MP, N, (int)gridDim.x, (int)blockIdx.x);
    pg8::gemm_phase<Epi>((LAS unsigned char*)smem, g, S, E);
}


__device__ void thin_gemm(CParams& p, unsigned char* smem, const bf16_t* A, int lda, const bf16_t* Bt, int N, int K, int kind, const float* rs_thin) {
    const int tid = get_tid(), lane = tid & 63, w = __builtin_amdgcn_readfirstlane(tid >> 6);
    float* RED = (float*)smem;
    unsigned char* ws = p.ws;
    const int nunits = N >> 5, kw = K >> 3;
    for (int u = get_bid(); u < nunits; u += gridDim.x) {
        const int pn = u >> 3, q = u & 7;
        const bf16_t* b0 = Bt + (size_t)(pn * 256 + 16 * q + (lane & 15)) * K + w * kw + (lane >> 4) * 8;
        const bf16_t* b1 = b0 + (size_t)128 * K;
        const bf16_t* ap = A + (size_t)(MP + (lane & 15)) * lda + w * kw + (lane >> 4) * 8;
        f32x4 acc0 = zero4(), acc1 = zero4();
#pragma unroll 4
        for (int k = 0; k < kw; k += 32) { const bf16x8 av = *(const bf16x8*)(ap + k), w0 = *(const bf16x8*)(b0 + k), w1 = *(const bf16x8*)(b1 + k);
            acc0 = __builtin_amdgcn_mfma_f32_16x16x32_bf16(w0, av, acc0, 0, 0, 0); acc1 = __builtin_amdgcn_mfma_f32_16x16x32_bf16(w1, av, acc1, 0, 0, 0); }
#pragma unroll
        for (int j = 0; j < 4; ++j) { RED[((w * 2 + 0) * 4 + j) * 64 + lane] = acc0[j]; RED[((w * 2 + 1) * 4 + j) * 64 + lane] = acc1[j]; }
        __syncthreads();
        if (tid < 128) {
            const int cl = tid >> 3, r = tid & 7, sl = (cl >> 2) * 16 + r, j = cl & 3; float v0 = 0.f, v1 = 0.f;
#pragma unroll
            for (int ww = 0; ww < 8; ++ww) { v0 += RED[((ww * 2 + 0) * 4 + j) * 64 + sl]; v1 += RED[((ww * 2 + 1) * 4 + j) * 64 + sl]; }
            const int c = 16 * q + cl; const size_t row = MP + r;
            if (kind == 0) { if (pn < 40) { bf16_t* zx = (bf16_t*)(ws + B_ZX) + row * ZLD + pn * 256 + c; zx[0] = f2bf(v0); zx[128] = f2bf(v1); } else if (c < 64) ((float*)(ws + B_DT))[row * 64 + c] = v0; }
            else if (kind == 1) { float* xr = (float*)(ws + B_XR) + row * 2048 + pn * 256 + c; const float* xs = rs_thin + (size_t)r * 2048 + pn * 256 + c; xr[0] = xs[0] + v0; xr[128] = xs[128] + v1; }
            else if (kind == 2) ((bf16_t*)(ws + B_H))[row * FF + pn * 128 + c] = f2bf(silu_f(v0) * v1);
            else if (pn >= 4 && pn < 8) { const int col = (pn - 4) * 256 + c; bf16_t* vb = (bf16_t*)(ws + B_VB) + row * 1024 + col; vb[0] = f2bf(v0); vb[128] = f2bf(v1);
                float* o = p.out + O_SV + (size_t)r * 1024 + col; o[0] = v0; o[128] = v1; }
            else { const bool isk = pn < 4; const int head = (isk ? pn : pn - 8) * 2 + (c >> 6), d = c & 63;
                const float cs = ((const float*)(ws + T_COS))[4096 * 64 + d], sn = ((const float*)(ws + T_SIN))[4096 * 64 + d];
                const float a = v0 * cs - v1 * sn, b = v1 * cs + v0 * sn;
                if (isk) { bf16_t* kb = (bf16_t*)(ws + B_KB) + row * 1024 + head * 128 + d; kb[0] = f2bf(a); kb[64] = f2bf(b); float* o = p.out + O_SK + (size_t)r * 1024 + head * 128 + d; o[0] = a; o[64] = b; }
                else { bf16_t* qb = (bf16_t*)(ws + B_QB) + row * 3072 + head * 128 + d; qb[0] = f2bf(a); qb[64] = f2bf(b); } }
        }
        __syncthreads();
    }
}

struct CvtJob { const float* src; const float* gain; bf16_t* dst; int N, K, kblk, map, nvalid; float scale; };
__device__ __forceinline__ CvtJob cvt_job(CParams& p, int j) {
    CvtJob r; r.gain = nullptr; r.map = 0; r.scale = 1.f;
    unsigned char* ws = p.ws;
    switch (j) {
    case 0: r.src = p.in[7]; r.gain = p.in[6]; r.dst = (bf16_t*)(ws + W_IN); r.N = 10304; r.K = 2048; r.kblk = 32; r.nvalid = 10304; break;
    case 1: r.src = p.in[14]; r.gain = p.in[13]; r.dst = (bf16_t*)(ws + W_OUT); r.N = 2048; r.K = 4096; r.kblk = 64; r.nvalid = 2048; break;
    case 2: r.src = p.in[21]; r.gain = p.in[20]; r.dst = (bf16_t*)(ws + W_GU0); r.N = 11264; r.K = 2048; r.kblk = 32; r.map = 1; r.nvalid = 11264; break;
    case 3: r.src = p.in[22]; r.dst = (bf16_t*)(ws + W_DN0); r.N = 2048; r.K = 5632; r.kblk = 88; r.nvalid = 2048; break;
    case 4: r.src = p.in[16]; r.gain = p.in[15]; r.dst = (bf16_t*)(ws + W_KVQ); r.N = 2048; r.K = 2048; r.kblk = 32; r.map = 3; r.nvalid = 2048; break;
    case 5: r.src = p.in[18]; r.gain = p.in[17]; r.dst = (bf16_t*)(ws + W_KVQ) + (size_t)2048 * 2048; r.N = 3072; r.K = 2048; r.kblk = 32; r.map = 2; r.nvalid = 3072; r.scale = 0.08838834764831845f; break;
    case 6: r.src = p.in[19]; r.dst = (bf16_t*)(ws + W_O); r.N = 2048; r.K = 1024; r.kblk = 16; r.nvalid = 2048; break;
    case 7: r.src = p.in[21] + (size_t)2048 * 11264; r.gain = p.in[20] + 2048; r.dst = (bf16_t*)(ws + W_GU1); r.N = 11264; r.K = 2048; r.kblk = 32; r.map = 1; r.nvalid = 11264; break;
    default: r.src = p.in[22] + (size_t)5632 * 2048; r.dst = (bf16_t*)(ws + W_DN1); r.N = 2048; r.K = 5632; r.kblk = 88; r.nvalid = 2048; break;
    }
    return r;
}
__device__ __forceinline__ int rope_src(int n0) { const int tile = n0 >> 8, within = n0 & 255, half = within >> 7, hh = (within & 127) >> 6; return (tile * 2 + hh) * 128 + half * 64; }

__device__ void convert_tiles(CParams& p, unsigned char* smem, int t0, int tstride, int tend) {
    const int tid = get_tid();
    unsigned* TP = (unsigned*)smem;
    const int n4 = tid & 63, kp = tid >> 6, nloc = 4 * n4;
    f32x4 v0[4], v1[4]; float g0[4], g1[4]; bf16_t* dstp = nullptr; int Kp = 0, n0p = 0, k0p = 0;
#define CVT_LOAD(tile_) do { const int _t = (tile_); int _j = 0; \
        if (_t >= 1312) _j = 1; if (_t >= 1824) _j = 2; if (_t >= 3232) _j = 3; if (_t >= 3936) _j = 4; if (_t >= 4192) _j = 5; if (_t >= 4576) _j = 6; if (_t >= 4704) _j = 7; if (_t >= 6112) _j = 8; \
        const int _jt = _j == 0 ? 0 : _j == 1 ? 1312 : _j == 2 ? 1824 : _j == 3 ? 3232 : _j == 4 ? 3936 : _j == 5 ? 4192 : _j == 6 ? 4576 : _j == 7 ? 4704 : 6112; \
        const CvtJob J = cvt_job(p, _j); const int _lt = _t - _jt; const int _nb = _lt / J.kblk, _kb = _lt % J.kblk; n0p = _nb * 256; k0p = _kb * 64; dstp = J.dst; Kp = J.K; \
        const int _nb64 = n0p + (nloc & ~63); int _sn = _nb64; \
        if (J.map == 1) { const int _pn = _nb64 >> 8, _w = _nb64 & 255; _sn = _w < 128 ? _pn * 128 + _w : FF + _pn * 128 + _w - 128; } \
        else if (J.map == 2) _sn = rope_src(_nb64); else if (J.map == 3) _sn = _nb64 < 1024 ? rope_src(_nb64) : _nb64; \
        _sn += nloc & 63; const bool _valid = _nb64 < J.nvalid; \
        _Pragma("unroll") for (int _i = 0; _i < 4; ++_i) { const int _k = k0p + 2 * (kp + 8 * _i); \
            if (_valid) { v0[_i] = __builtin_nontemporal_load((const f32x4*)(J.src + (size_t)_k * J.N + _sn)); v1[_i] = __builtin_nontemporal_load((const f32x4*)(J.src + (size_t)(_k + 1) * J.N + _sn)); } else { v0[_i] = zero4(); v1[_i] = zero4(); } \
            g0[_i] = J.gain ? J.gain[_k] * J.scale : J.scale; g1[_i] = J.gain ? J.gain[_k + 1] * J.scale : J.scale; } } while (0)
    int tile = t0, buf = 0;
    if (tile < tend) CVT_LOAD(tile);
    while (tile < tend) {
        unsigned* T = TP + buf * (32 * 258);
#pragma unroll
        for (int i = 0; i < 4; ++i) { unsigned* tp = T + (kp + 8 * i) * 258 + nloc;
            *(u32x2*)tp = (u32x2){pk2(v0[i][0] * g0[i], v1[i][0] * g1[i]), pk2(v0[i][1] * g0[i], v1[i][1] * g1[i])};
            *(u32x2*)(tp + 2) = (u32x2){pk2(v0[i][2] * g0[i], v1[i][2] * g1[i]), pk2(v0[i][3] * g0[i], v1[i][3] * g1[i])}; }
        bf16_t* dsto = dstp; const int Ko = Kp, n0o = n0p, k0o = k0p;
        __syncthreads();
        const int nt = tile + tstride;
        if (nt < tend) CVT_LOAD(nt);
#pragma unroll
        for (int i = 0; i < 4; ++i) { const int q = tid + NTHR * i, n = q >> 3, c = q & 7;
            const u32x4 o = (u32x4){T[(4 * c) * 258 + n], T[(4 * c + 1) * 258 + n], T[(4 * c + 2) * 258 + n], T[(4 * c + 3) * 258 + n]};
            *(u32x4*)(dsto + (size_t)(n0o + n) * Ko + k0o + 8 * c) = o; }
        buf ^= 1; tile = nt;
    }
#undef CVT_LOAD
    __syncthreads();
}
__device__ void phase_convert(CParams& p, unsigned char* smem) {
    const int tid = get_tid();
    float* COS = (float*)(p.ws + T_COS); float* SIN = (float*)(p.ws + T_SIN);
    for (int i = get_bid() * NTHR + tid; i < 4097 * 64; i += gridDim.x * NTHR) {
        const int pi = i >> 6, d = i & 63; const float pos = pi < 4096 ? (float)pi : 16384.f;
        const float inv = powf(10000.f, -(float)d / 64.f); const float ang = pos * inv;
        COS[i] = cosf(ang); SIN[i] = sinf(ang);
    }
}

template <int MODE>
__device__ void phase_rmsnorm(CParams& p) {
    const int tid = get_tid(), lane = tid & 63, w = __builtin_amdgcn_readfirstlane(tid >> 6);
    const float* XR = (const float*)(p.ws + B_XR); bf16_t* XN = (bf16_t*)(p.ws + B_XN);
    for (int row = get_bid() * 8 + w; row < MV; row += gridDim.x * 16) {
        const int rowb = row + gridDim.x * 8; const bool hasb = rowb < MV; const int rb = hasb ? rowb : row;
        const float* sa; const float* sb;
        if (MODE == 0) { sa = row < MP ? p.in[0] + (size_t)row * DM : p.in[1] + (size_t)(row - MP) * DM; sb = rb < MP ? p.in[0] + (size_t)rb * DM : p.in[1] + (size_t)(rb - MP) * DM; }
        else { sa = XR + (size_t)row * DM; sb = XR + (size_t)rb * DM; }
        f32x4 va[8], vb[8]; float ssa = 0.f, ssb = 0.f;
#pragma unroll
        for (int i = 0; i < 8; ++i) { if (MODE == 0) { va[i] = __builtin_nontemporal_load((const f32x4*)(sa + lane * 4 + 256 * i)); vb[i] = __builtin_nontemporal_load((const f32x4*)(sb + lane * 4 + 256 * i)); }
            else { va[i] = *(const f32x4*)(sa + lane * 4 + 256 * i); vb[i] = *(const f32x4*)(sb + lane * 4 + 256 * i); } }
#pragma unroll
        for (int i = 0; i < 8; ++i) { ssa += va[i][0] * va[i][0] + va[i][1] * va[i][1] + va[i][2] * va[i][2] + va[i][3] * va[i][3]; ssb += vb[i][0] * vb[i][0] + vb[i][1] * vb[i][1] + vb[i][2] * vb[i][2] + vb[i][3] * vb[i][3]; }
        ssa = wave_sum(ssa, lane); ssb = wave_sum(ssb, lane);
        const float s0 = rsqrtf(ssa * (1.f / DM) + EPS), s1 = rsqrtf(ssb * (1.f / DM) + EPS);
#pragma unroll
        for (int i = 0; i < 8; ++i) { const int c = lane * 4 + 256 * i;
            if (MODE == 2) { const f32x4 gn = *(const f32x4*)(p.in[23] + c); *(f32x4*)(p.out + (size_t)row * DM + c) = va[i] * s0 * gn; if (hasb) *(f32x4*)(p.out + (size_t)rowb * DM + c) = vb[i] * s1 * gn; }
            else { *(u32x2*)(XN + (size_t)row * DM + c) = (u32x2){pk2(va[i][0] * s0, va[i][1] * s0), pk2(va[i][2] * s0, va[i][3] * s0)};
                if (hasb) *(u32x2*)(XN + (size_t)rowb * DM + c) = (u32x2){pk2(vb[i][0] * s1, vb[i][1] * s1), pk2(vb[i][2] * s1, vb[i][3] * s1)}; } }
    }
}

__device__ __forceinline__ void ssd_prep(CParams& p, float* ACS, float* DTV, float* WSC, float* CD, int b, int c, int g) {
    const int tid = get_tid(), lane = tid & 63, w = __builtin_amdgcn_readfirstlane(tid >> 6), hd = g * 8 + w;
    const float* DT = (const float*)(p.ws + B_DT); const int row0 = b * SEQ + c * 128;
    const float bias = p.in[10][hd], A = -__expf(p.in[11][hd]);
    const float d0 = softplus_f(DT[(size_t)(row0 + 2 * lane) * 64 + hd] + bias), d1 = softplus_f(DT[(size_t)(row0 + 2 * lane + 1) * 64 + hd] + bias);
    const float a0 = d0 * A, a1 = d1 * A, s = a0 + a1; float incl = s;
    for (int o = 1; o < 64; o <<= 1) { const float t = shl(incl, (lane - o) & 63); if (lane >= o) incl += t; }
    const float excl = incl - s, c0 = excl + a0, c1 = excl + s, tot = shl(incl, 63);
    ACS[w * 128 + 2 * lane] = c0; ACS[w * 128 + 2 * lane + 1] = c1; DTV[w * 128 + 2 * lane] = d0; DTV[w * 128 + 2 * lane + 1] = d1;
    if (WSC) { WSC[w * 128 + 2 * lane] = d0 * __expf(tot - c0); WSC[w * 128 + 2 * lane + 1] = d1 * __expf(tot - c1); }
    if (CD && lane == 0) CD[(b * 32 + c) * 64 + hd] = __expf(tot);
}
template <int NC, bool TRANS>
__device__ __forceinline__ void stage_conv(bf16_t* dst, const bf16_t* src, bool first, const float* cw, const float* cb, const float* rowscale) {
    constexpr int CP = NC / 2, RG = NTHR / CP, RPT = 128 / RG;
    const int tid = get_tid(), cp = tid % CP, rg = tid / CP, ch = 2 * cp, r0 = rg * RPT;
    float w[4][2], bb[2];
#pragma unroll
    for (int k = 0; k < 4; ++k) { w[k][0] = cw[k * CONVD + ch]; w[k][1] = cw[k * CONVD + ch + 1]; }
    bb[0] = cb[ch]; bb[1] = cb[ch + 1];
    float xa[2], xb[2], xc[2];
#define LDROW(r, o) do { if (first && (r) < 0) { o[0] = 0.f; o[1] = 0.f; } else { const unsigned _v = *(const unsigned*)(src + (long)(r) * ZLD + ch); o[0] = bf2f(_v & 0xffffu); o[1] = bf2f(_v >> 16); } } while (0)
    LDROW(r0 - 3, xa); LDROW(r0 - 2, xb); LDROW(r0 - 1, xc);
    float ov[2][RPT];
#pragma unroll
    for (int i = 0; i < RPT; ++i) {
        float xd[2]; LDROW(r0 + i, xd);
#pragma unroll
        for (int e = 0; e < 2; ++e) { float v = bb[e] + w[0][e] * xa[e] + w[1][e] * xb[e] + w[2][e] * xc[e] + w[3][e] * xd[e]; v = silu_f(v);
            if (TRANS && rowscale) v *= rowscale[(ch >> 6) * 128 + r0 + i];
            ov[e][i] = v; xa[e] = xb[e]; xb[e] = xc[e]; xc[e] = xd[e]; }
        if (!TRANS) *(unsigned*)(dst + (r0 + i) * 136 + ch) = pk2(ov[0][i], ov[1][i]);
    }
#undef LDROW
    if (TRANS) {
#pragma unroll
        for (int e = 0; e < 2; ++e)
#pragma unroll
            for (int q = 0; q < RPT / 8; ++q)
                *(u32x4*)(dst + (ch + e) * 136 + r0 + q * 8) = (u32x4){pk2(ov[e][q * 8], ov[e][q * 8 + 1]), pk2(ov[e][q * 8 + 2], ov[e][q * 8 + 3]), pk2(ov[e][q * 8 + 4], ov[e][q * 8 + 5]), pk2(ov[e][q * 8 + 6], ov[e][q * 8 + 7])};
    }
}

__device__ __forceinline__ void conv_from_raw(bf16_t* dst, const unsigned (&raw)[19], const float* cw, const float* cb, const float* rowscale, int ch, int r0) {
    float w[4][2], bb[2];
#pragma unroll
    for (int k = 0; k < 4; ++k) { w[k][0] = cw[k * CONVD + ch]; w[k][1] = cw[k * CONVD + ch + 1]; }
    bb[0] = cb[ch]; bb[1] = cb[ch + 1];
    float ov[2][16];
#pragma unroll
    for (int i = 0; i < 16; ++i)
#pragma unroll
        for (int e = 0; e < 2; ++e) { float v = bb[e];
#pragma unroll
            for (int k = 0; k < 4; ++k) { const unsigned xr = raw[i + k]; v += w[k][e] * (e ? bf2f(xr >> 16) : bf2f(xr & 0xffffu)); }
            v = silu_f(v); if (rowscale) v *= rowscale[(ch >> 6) * 128 + r0 + i]; ov[e][i] = v; }
#pragma unroll
    for (int e = 0; e < 2; ++e)
#pragma unroll
        for (int q = 0; q < 2; ++q)
            *(u32x4*)(dst + (ch + e) * 136 + r0 + q * 8) = (u32x4){pk2(ov[e][q * 8], ov[e][q * 8 + 1]), pk2(ov[e][q * 8 + 2], ov[e][q * 8 + 3]), pk2(ov[e][q * 8 + 4], ov[e][q * 8 + 5]), pk2(ov[e][q * 8 + 6], ov[e][q * 8 + 7])};
}
__device__ __forceinline__ void conv_from_raw_nat(bf16_t* dst, const unsigned (&raw)[19], const float* cw, const float* cb, int ch, int r0) {
    float w[4][2], bb[2];
#pragma unroll
    for (int k = 0; k < 4; ++k) { w[k][0] = cw[k * CONVD + ch]; w[k][1] = cw[k * CONVD + ch + 1]; }
    bb[0] = cb[ch]; bb[1] = cb[ch + 1];
#pragma unroll
    for (int i = 0; i < 16; ++i) { float v[2];
#pragma unroll
        for (int e = 0; e < 2; ++e) { float t = bb[e];
#pragma unroll
            for (int k = 0; k < 4; ++k) { const unsigned xr = raw[i + k]; t += w[k][e] * (e ? bf2f(xr >> 16) : bf2f(xr & 0xffffu)); }
            v[e] = silu_f(t); }
        *(unsigned*)(dst + (r0 + i) * 136 + ch) = pk2(v[0], v[1]); }
}
__device__ void ssd_state_item(CParams& p, unsigned char* smem, int b, int c, int g) {
    const int tid = get_tid(), lane = tid & 63, w = __builtin_amdgcn_readfirstlane(tid >> 6);
    float* ACS = (float*)smem; float* DTV = ACS + 1024; float* WSC = DTV + 1024;
    bf16_t* BT = (bf16_t*)(smem + 12288); bf16_t* XT = (bf16_t*)(smem + 47104);
    const bf16_t* ZX = (const bf16_t*)(p.ws + B_ZX); bf16_t* ST = (bf16_t*)(p.ws + B_ST); float* CD = (float*)(p.ws + B_CD);
    const bf16_t* zrow = ZX + (size_t)(b * SEQ + c * 128) * ZLD + DIN;
    const int ch = 2 * (tid & 63), r0 = (tid >> 6) * 16;
    unsigned rawB[19], rawX[4][19];
#define LOADROWS(dst_, src_) do { _Pragma("unroll") for (int _i = 0; _i < 19; ++_i) { const int _r = r0 - 3 + _i; dst_[_i] = (c == 0 && _r < 0) ? 0u : *(const unsigned*)((src_) + (long)_r * ZLD + ch); } } while (0)
    LOADROWS(rawB, zrow + DIN + g * 128);
#pragma unroll
    for (int q = 0; q < 4; ++q) LOADROWS(rawX[q], zrow + g * 512 + q * 128);
#undef LOADROWS
    ssd_prep(p, ACS, DTV, WSC, CD, b, c, g);
    conv_from_raw(BT, rawB, p.in[8] + DIN + g * 128, p.in[9] + DIN + g * 128, nullptr, ch, r0);
    __syncthreads();
#pragma unroll
    for (int hb = 0; hb < 2; ++hb) {
        const int ch0 = g * 512 + hb * 256;
        conv_from_raw(XT, rawX[2 * hb], p.in[8] + ch0, p.in[9] + ch0, WSC + (hb * 4) * 128, ch, r0);
        conv_from_raw(XT + 128 * 136, rawX[2 * hb + 1], p.in[8] + ch0 + 128, p.in[9] + ch0 + 128, WSC + (hb * 4 + 2) * 128, ch, r0);
        __syncthreads();
        f32x4 acc[2][8];
#pragma unroll
        for (int i = 0; i < 2; ++i)
#pragma unroll
            for (int n = 0; n < 8; ++n) acc[i][n] = zero4();
#pragma unroll
        for (int ks = 0; ks < 4; ++ks) {
            const bf16x8 a0 = frag_ld(XT, 136, 32 * w, 32 * ks, lane), a1 = frag_ld(XT, 136, 32 * w + 16, 32 * ks, lane); bf16x8 bfr[8];
#pragma unroll
            for (int n = 0; n < 8; ++n) bfr[n] = frag_ld(BT, 136, 16 * n, 32 * ks, lane);
            __builtin_amdgcn_sched_barrier(0);
#pragma unroll
            for (int n = 0; n < 8; ++n) {
                acc[0][n] = __builtin_amdgcn_mfma_f32_16x16x32_bf16(bfr[n], a0, acc[0][n], 0, 0, 0);
                acc[1][n] = __builtin_amdgcn_mfma_f32_16x16x32_bf16(bfr[n], a1, acc[1][n], 0, 0, 0); }
        }
#pragma unroll
        for (int i = 0; i < 2; ++i) { const int pp = 32 * w + 16 * i + (lane & 15); const int hd = g * 8 + hb * 4 + (pp >> 6);
            bf16_t* sp = ST + ((size_t)((b * 32 + c) * 64 + hd) * 64 + (pp & 63)) * 128 + (lane >> 4) * 4;
#pragma unroll
            for (int n = 0; n < 8; ++n) *(u32x2*)(sp + 16 * n) = (u32x2){pk2(acc[i][n][0], acc[i][n][1]), pk2(acc[i][n][2], acc[i][n][3])}; }
        __syncthreads();
    }
}

__device__ void ssd_sample_item(CParams& p, unsigned char* smem, int bs, int hd) {
    const int tid = get_tid(), lane = tid & 63;
    float* XS = (float*)smem; float* BS = XS + 64; float* CS = BS + 128;
    bf16_t* ZX = (bf16_t*)(p.ws + B_ZX); const float* DT = (const float*)(p.ws + B_DT);
    bf16_t* zxrow = ZX + (size_t)(MP + bs) * ZLD; const int g = hd >> 3;
    const int pp = tid >> 3, nc = (tid & 7) * 16; const size_t off = (((size_t)bs * 64 + hd) * 64 + pp) * 128 + nc;
    f32x4 h[4];
#pragma unroll
    for (int i = 0; i < 4; ++i) h[i] = *(const f32x4*)(p.in[3] + off + 4 * i);
    if (tid < 320) { const int ch = tid < 64 ? hd * 64 + tid : (tid < 192 ? DIN + g * 128 + tid - 64 : DIN + 1024 + g * 128 + tid - 192);
        const float* sc = p.in[2] + (size_t)bs * 3 * CONVD; const float* cw = p.in[8];
        const float v = p.in[9][ch] + cw[ch] * sc[ch] + cw[CONVD + ch] * sc[CONVD + ch] + cw[2 * CONVD + ch] * sc[2 * CONVD + ch] + cw[3 * CONVD + ch] * bf2f(zxrow[DIN + ch]);
        XS[tid] = silu_f(v); }
    const float dt = softplus_f(DT[(size_t)(MP + bs) * 64 + hd] + p.in[10][hd]); const float dae = __expf(dt * -__expf(p.in[11][hd]));
    __syncthreads();
    const float xd = dt * XS[pp]; float y = 0.f;
#pragma unroll
    for (int i = 0; i < 4; ++i) { const f32x4 bv = *(const f32x4*)(BS + nc + 4 * i), cv = *(const f32x4*)(CS + nc + 4 * i);
        h[i] = h[i] * dae + xd * bv; *(f32x4*)(p.out + O_SSSM + off + 4 * i) = h[i];
        y += h[i][0] * cv[0] + h[i][1] * cv[1] + h[i][2] * cv[2] + h[i][3] * cv[3]; }
    y += SHX(y, 1); y += SHX(y, 2); y += SHX(y, 4);
    if ((tid & 7) == 0) { y += p.in[12][hd] * XS[pp]; const float z = bf2f(zxrow[hd * 64 + pp]); zxrow[hd * 64 + pp] = f2bf(y * silu_f(z)); }
    __syncthreads();
}

__device__ void phase_ssd_states(CParams& p, unsigned char* smem) {
    for (int it = get_bid(); it < 1024; it += gridDim.x) {
        if (it < 512) ssd_state_item(p, smem, it >> 8, (it >> 3) & 31, it & 7);
        else ssd_sample_item(p, smem, (it - 512) >> 6, (it - 512) & 63);
    }
    const bf16_t* ZX = (const bf16_t*)(p.ws + B_ZX);
    for (int i = get_bid() * NTHR + get_tid(); i < 2 * 3 * CONVD; i += gridDim.x * NTHR) { const int b = i / (3 * CONVD), r = (i / CONVD) % 3, ch = i % CONVD;
        p.out[O_PCONV + i] = bf2f(ZX[(size_t)(b * SEQ + SEQ - 3 + r) * ZLD + DIN + ch]); }
    for (int i = get_bid() * NTHR + get_tid(); i < 8 * 3 * CONVD; i += gridDim.x * NTHR) { const int bs = i / (3 * CONVD), r = (i / CONVD) % 3, ch = i % CONVD;
        p.out[O_SCONV + i] = r < 2 ? p.in[2][(size_t)(bs * 3 + r + 1) * CONVD + ch] : bf2f(ZX[(size_t)(MP + bs) * ZLD + DIN + ch]); }
}

__device__ void phase_scan(CParams& p) {
    const bf16_t* ST = (const bf16_t*)(p.ws + B_ST); bf16_t* HPV = (bf16_t*)(p.ws + B_HPV); const float* CD = (const float*)(p.ws + B_CD);
    for (int i = get_bid() * NTHR + get_tid(); i < 2 * 64 * 1024; i += gridDim.x * NTHR) {
        const int b = i >> 16, rem = i & 65535, hd = rem >> 10, e8 = rem & 1023;
        float h[8];
#pragma unroll
        for (int e = 0; e < 8; ++e) h[e] = 0.f;
        for (int c0 = 0; c0 < 32; c0 += 8) {
            u32x4 v[8];
#pragma unroll
            for (int k = 0; k < 8; ++k) v[k] = *(const u32x4*)(ST + ((size_t)((b * 32 + c0 + k) * 64 + hd)) * 8192 + e8 * 8);
#pragma unroll
            for (int k = 0; k < 8; ++k) { const float cd = CD[(b * 32 + c0 + k) * 64 + hd];
                *(u32x4*)(HPV + ((size_t)((b * 32 + c0 + k) * 64 + hd)) * 8192 + e8 * 8) = (u32x4){pk2(h[0], h[1]), pk2(h[2], h[3]), pk2(h[4], h[5]), pk2(h[6], h[7])};
#pragma unroll
                for (int e = 0; e < 4; ++e) { h[2 * e] = h[2 * e] * cd + bf2f(v[k][e] & 0xffffu); h[2 * e + 1] = h[2 * e + 1] * cd + bf2f(v[k][e] >> 16); } }
        }
        float* o = p.out + O_PSSM + ((size_t)(b * 64 + hd)) * 8192 + e8 * 8;
        *(f32x4*)o = (f32x4){h[0], h[1], h[2], h[3]}; *(f32x4*)(o + 4) = (f32x4){h[4], h[5], h[6], h[7]};
    }
}

__device__ void ssd_out_item(CParams& p, unsigned char* smem, int b, int c, int g) {
    const int tid = get_tid(), lane = tid & 63, w = __builtin_amdgcn_readfirstlane(tid >> 6);
    float* ACS = (float*)smem; float* DTV = ACS + 1024;
    bf16_t* CL = (bf16_t*)(smem + 8192); bf16_t* BL = (bf16_t*)(smem + 43008); bf16_t* CB = (bf16_t*)(smem + 77824);
    bf16_t* XT = BL; bf16_t* HP = BL + 64 * 136;
    bf16_t* ZX = (bf16_t*)(p.ws + B_ZX); const bf16_t* ST = (const bf16_t*)(p.ws + B_HPV); float* GS = (float*)(p.ws + B_GS);
    const int row0 = b * SEQ + c * 128;
    const bf16_t* zrow = ZX + (size_t)row0 * ZLD + DIN;
    const int chq = 2 * (tid & 63), r0q = (tid >> 6) * 16;
    unsigned rawC[19], rawBq[19];
#pragma unroll
    for (int i = 0; i < 19; ++i) { const int r = r0q - 3 + i; const bool zr = (c == 0 && r < 0);
        rawC[i] = zr ? 0u : *(const unsigned*)(zrow + DIN + 1024 + g * 128 + (long)r * ZLD + chq);
        rawBq[i] = zr ? 0u : *(const unsigned*)(zrow + DIN + g * 128 + (long)r * ZLD + chq); }
    ssd_prep(p, ACS, DTV, nullptr, nullptr, b, c, g);
    conv_from_raw_nat(CL, rawC, p.in[8] + DIN + 1024 + g * 128, p.in[9] + DIN + 1024 + g * 128, chq, r0q);
    conv_from_raw_nat(BL, rawBq, p.in[8] + DIN + g * 128, p.in[9] + DIN + g * 128, chq, r0q);
    __syncthreads();
    {
        f32x4 cacc[8];
#pragma unroll
        for (int n = 0; n < 8; ++n) cacc[n] = zero4();
#pragma unroll
        for (int ks = 0; ks < 4; ++ks) { const bf16x8 a = frag_ld(CL, 136, 16 * w, 32 * ks, lane);
#pragma unroll
            for (int n = 0; n < 8; ++n) if (n <= (w | 1)) { const bf16x8 bf = frag_ld(BL, 136, 16 * n, 32 * ks, lane); cacc[n] = __builtin_amdgcn_mfma_f32_16x16x32_bf16(a, bf, cacc[n], 0, 0, 0); } }
#pragma unroll
        for (int n = 0; n < 8; ++n) if (n <= (w | 1)) {
#pragma unroll
            for (int j = 0; j < 4; ++j) CB[(16 * w + (lane >> 4) * 4 + j) * 136 + 16 * n + (lane & 15)] = f2bf(cacc[n][j]); }
    }
    __syncthreads();
    float ssq = 0.f;
    const int l_a = 16 * w + (lane & 15);
    const int kmax = (16 * w + 15) >> 5;
    const int cpx = tid & 31, rgx = tid >> 5, chx = 2 * cpx, r0x = rgx * 8;
    const int ppx = tid >> 3, ncx = (tid & 7) * 16;
    unsigned xraw[11]; u32x4 hraw[2]; u32x2 zraw[4];
#define SSD_PREFETCH(rr) do { const int _hd = g * 8 + (rr); const bf16_t* _src = zrow + _hd * 64 + chx; \
        _Pragma("unroll") for (int _i = 0; _i < 11; ++_i) { const int _r = r0x - 3 + _i; xraw[_i] = (c == 0 && _r < 0) ? 0u : *(const unsigned*)(_src + (long)_r * ZLD); } \
        const bf16_t* _hp = ST + ((size_t)((b * 32 + c) * 64 + _hd) * 64 + ppx) * 128 + ncx; hraw[0] = *(const u32x4*)_hp; hraw[1] = *(const u32x4*)(_hp + 8); \
        { const bf16_t* _zr = ZX + (size_t)(row0 + 16 * w + (lane & 15)) * ZLD + _hd * 64 + (lane >> 4) * 4; \
            _Pragma("unroll") for (int _pt = 0; _pt < 4; ++_pt) zraw[_pt] = *(const u32x2*)(_zr + 16 * _pt); } } while (0)
    SSD_PREFETCH(0);
    for (int r = 0; r < 8; ++r) {
        const int hd = g * 8 + r;
        {
            const float* cw = p.in[8] + hd * 64 + chx; const float* cb = p.in[9] + hd * 64 + chx;
            float wv[4][2], bb[2];
#pragma unroll
            for (int k = 0; k < 4; ++k) { wv[k][0] = cw[k * CONVD]; wv[k][1] = cw[k * CONVD + 1]; }
            bb[0] = cb[0]; bb[1] = cb[1];
            float ov[2][8];
#pragma unroll
            for (int i = 0; i < 8; ++i)
#pragma unroll
                for (int e = 0; e < 2; ++e) { float v = bb[e];
#pragma unroll
                    for (int k = 0; k < 4; ++k) { const unsigned xr = xraw[i + k]; v += wv[k][e] * (e ? bf2f(xr >> 16) : bf2f(xr & 0xffffu)); }
                    ov[e][i] = silu_f(v); }
#pragma unroll
            for (int e = 0; e < 2; ++e)
                *(u32x4*)(XT + (chx + e) * 136 + r0x) = (u32x4){pk2(ov[e][0], ov[e][1]), pk2(ov[e][2], ov[e][3]), pk2(ov[e][4], ov[e][5]), pk2(ov[e][6], ov[e][7])};
            *(u32x4*)(HP + ppx * 136 + ncx) = hraw[0]; *(u32x4*)(HP + ppx * 136 + ncx + 8) = hraw[1];
        }
        u32x2 zcur[4];
#pragma unroll
        for (int i = 0; i < 4; ++i) zcur[i] = zraw[i];
        __syncthreads();
        if (r < 7) SSD_PREFETCH(r + 1);
        f32x4 acc[4];
#pragma unroll
        for (int pt = 0; pt < 4; ++pt) acc[pt] = zero4();
#pragma unroll
        for (int ks = 0; ks < 4; ++ks) { const bf16x8 a = frag_ld(CL, 136, 16 * w, 32 * ks, lane); bf16x8 hf[4];
#pragma unroll
            for (int pt = 0; pt < 4; ++pt) hf[pt] = frag_ld(HP, 136, 16 * pt, 32 * ks, lane);
            __builtin_amdgcn_sched_barrier(0);
#pragma unroll
            for (int pt = 0; pt < 4; ++pt) acc[pt] = __builtin_amdgcn_mfma_f32_16x16x32_bf16(hf[pt], a, acc[pt], 0, 0, 0); }
        { const float e = __expf(ACS[r * 128 + l_a]);
#pragma unroll
          for (int pt = 0; pt < 4; ++pt) acc[pt] = acc[pt] * e; }
        const float acl = ACS[r * 128 + l_a];
        for (int ks = 0; ks <= kmax; ++ks) {
            const int s0 = 32 * ks + (lane >> 4) * 8;
            const bf16x8 cbv = *(const bf16x8*)(CB + l_a * 136 + s0);
            const f32x4 as0 = *(const f32x4*)(ACS + r * 128 + s0), as1 = *(const f32x4*)(ACS + r * 128 + s0 + 4);
            const f32x4 dt0 = *(const f32x4*)(DTV + r * 128 + s0), dt1 = *(const f32x4*)(DTV + r * 128 + s0 + 4);
            float vv[8];
#pragma unroll
            for (int i = 0; i < 8; ++i) { const float asv = i < 4 ? as0[i & 3] : as1[i & 3]; const float dtv = i < 4 ? dt0[i & 3] : dt1[i & 3];
                const float x = bf2f((unsigned)(unsigned short)cbv[i]) * __expf(fminf(acl - asv, 0.f)) * dtv; vv[i] = (s0 + i <= l_a) ? x : 0.f; }
            const u32x4 au = (u32x4){pk2(vv[0], vv[1]), pk2(vv[2], vv[3]), pk2(vv[4], vv[5]), pk2(vv[6], vv[7])};
            bf16x8 a; __builtin_memcpy(&a, &au, 16);
            bf16x8 xf[4];
#pragma unroll
            for (int pt = 0; pt < 4; ++pt) xf[pt] = frag_ld(XT, 136, 16 * pt, 32 * ks, lane);
            __builtin_amdgcn_sched_barrier(0);
#pragma unroll
            for (int pt = 0; pt < 4; ++pt) acc[pt] = __builtin_amdgcn_mfma_f32_16x16x32_bf16(xf[pt], a, acc[pt], 0, 0, 0);
        }
        const float Dh = p.in[12][hd];
        { bf16_t* zr = ZX + (size_t)(row0 + l_a) * ZLD + hd * 64 + (lane >> 4) * 4;
#pragma unroll
          for (int pt = 0; pt < 4; ++pt) { float y[4];
#pragma unroll
              for (int j = 0; j < 4; ++j) { const int pp = 16 * pt + (lane >> 4) * 4 + j; const float xs = bf2f(XT[pp * 136 + l_a]);
                  const unsigned zw = zcur[pt][j >> 1]; const float z = (j & 1) ? bf2f(zw >> 16) : bf2f(zw & 0xffffu);
                  y[j] = (acc[pt][j] + Dh * xs) * silu_f(z); ssq += y[j] * y[j]; }
              *(u32x2*)(zr + 16 * pt) = (u32x2){pk2(y[0], y[1]), pk2(y[2], y[3])}; } }
        __syncthreads();
    }
#undef SSD_PREFETCH
    { float sq = ssq; sq += SHX(sq, 16); sq += SHX(sq, 32);
      if ((lane >> 4) == 0) GS[(size_t)(row0 + l_a) * 8 + g] = rsqrtf(sq * (1.f / 512.f) + EPS); }
}
__device__ void phase_ssd_out(CParams& p, unsigned char* smem) {
    for (int it = get_bid(); it < 512; it += gridDim.x) { ssd_out_item(p, smem, it >> 8, (it >> 3) & 31, it & 7); __syncthreads(); }
}
__device__ void phase_gnorm(CParams& p) {
    const int tid = get_tid(), lane = tid & 63, w = __builtin_amdgcn_readfirstlane(tid >> 6);
    bf16_t* ZX = (bf16_t*)(p.ws + B_ZX); const float* GS = (const float*)(p.ws + B_GS);
    for (int row = get_bid() * 8 + w; row < MV; row += gridDim.x * 8) {
#pragma unroll
        for (int i = 0; i < 8; ++i) { const int ch = (lane + 64 * i) * 8;
            u32x4* q = (u32x4*)(ZX + (size_t)row * ZLD + ch); const u32x4 v = *q; u32x4 o; float s;
            if (row < MP) s = GS[(size_t)row * 8 + i];
            else { float ss = 0.f;
#pragma unroll
                for (int e = 0; e < 4; ++e) { const float a = bf2f(v[e] & 0xffffu), b = bf2f(v[e] >> 16); ss += a * a + b * b; }
                ss = wave_sum(ss, lane); s = rsqrtf(ss * (1.f / 512.f) + EPS); }
#pragma unroll
            for (int e = 0; e < 4; ++e) o[e] = pk2(bf2f(v[e] & 0xffffu) * s, bf2f(v[e] >> 16) * s);
            *q = o; }
    }
}

struct AttStep { int it, kb, qb, g, h, rate, rowbase, ok; };
__device__ __forceinline__ void att_decode(AttStep& s) {
    s.ok = s.it < 1536 ? 1 : 0; if (!s.ok) return;
    const int bh = s.it / 96, r = s.it % 96; const int b = bh >> 3; s.h = bh & 7; int rho;
    if (r < 32) { s.g = 0; rho = 0; s.qb = r; } else if (r < 64) { s.g = 1; rho = (r - 32) >> 3; s.qb = (r - 32) & 7; } else { s.g = 2; rho = (r - 64) >> 1; s.qb = (r - 64) & 1; }
    s.rate = s.g == 0 ? 1 : (s.g == 1 ? 4 : 16); s.rowbase = b * SEQ + rho; s.kb = s.qb > 0 ? s.qb - 1 : 0;
}
__device__ void attn_prompt(CParams& p, unsigned char* smem) {
    const int tid = get_tid(), lane = tid & 63, w = __builtin_amdgcn_readfirstlane(tid >> 6);
    bf16_t* KT = (bf16_t*)smem; bf16_t* VT = (bf16_t*)(smem + 34816); bf16_t* PW = (bf16_t*)(smem + 69632) + w * 16 * 136;
    const bf16_t* KB = (const bf16_t*)(p.ws + B_KB); const bf16_t* VB = (const bf16_t*)(p.ws + B_VB); const bf16_t* QB = (const bf16_t*)(p.ws + B_QB);
    bf16_t* OP = (bf16_t*)(p.ws + B_OP); float* LSE = (float*)(p.ws + B_LSE);
    AttStep cur; cur.it = get_bid(); att_decode(cur);
    u32x4 kraw[4], vraw[4];
#define ATT_PREFETCH(S) do { \
        _Pragma("unroll") for (int _i = 0; _i < 4; ++_i) { const int _idx = tid + NTHR * _i, _key = _idx >> 4, _chn = _idx & 15; \
            kraw[_i] = *(const u32x4*)(KB + (size_t)((S).rowbase + (S).rate * (128 * (S).kb + _key)) * 1024 + (S).h * 128 + _chn * 8); } \
        { const int _kp = tid & 63, _dq = tid >> 6; const bf16_t* _v0 = VB + (size_t)((S).rowbase + (S).rate * (128 * (S).kb + 2 * _kp)) * 1024 + (S).h * 128 + _dq * 16; const bf16_t* _v1 = _v0 + (size_t)(S).rate * 1024; \
          vraw[0] = *(const u32x4*)_v0; vraw[1] = *(const u32x4*)(_v0 + 8); vraw[2] = *(const u32x4*)_v1; vraw[3] = *(const u32x4*)(_v1 + 8); } } while (0)
    bf16x8 qnext[4];
#define ATT_QPREFETCH(S) do { const size_t _qrow = (size_t)((S).rowbase + (S).rate * (128 * (S).qb + 16 * w + (lane & 15))); \
        _Pragma("unroll") for (int _ks = 0; _ks < 4; ++_ks) qnext[_ks] = *(const bf16x8*)(QB + _qrow * 3072 + ((S).g * 8 + (S).h) * 128 + 32 * _ks + (lane >> 4) * 8); } while (0)
    if (cur.ok) { ATT_PREFETCH(cur); ATT_QPREFETCH(cur); }
    bf16x8 qf[4]; float mrow[4], lrow[4]; f32x4 o[8];
    while (cur.ok) {
#pragma unroll
        for (int i = 0; i < 4; ++i) { const int idx = tid + NTHR * i, key = idx >> 4, chn = idx & 15; *(u32x4*)(KT + key * 136 + chn * 8) = kraw[i]; }
        { const int kp = tid & 63, dq = tid >> 6;
#pragma unroll
          for (int i = 0; i < 2; ++i)
#pragma unroll
              for (int e = 0; e < 4; ++e) { const unsigned a = vraw[i][e], b = vraw[2 + i][e]; const int d = dq * 16 + 8 * i + 2 * e;
                  *(unsigned*)(VT + d * 136 + 2 * kp) = (a & 0xffffu) | (b << 16); *(unsigned*)(VT + (d + 1) * 136 + 2 * kp) = (a >> 16) | (b & 0xffff0000u); } }
        __syncthreads();
        AttStep nxt = cur;
        if (cur.kb < cur.qb) nxt.kb = cur.kb + 1; else { nxt.it = cur.it + gridDim.x; att_decode(nxt); }
        const bool first = cur.kb == (cur.qb > 0 ? cur.qb - 1 : 0), last = cur.kb == cur.qb;
        if (first) {
#pragma unroll
            for (int ks = 0; ks < 4; ++ks) qf[ks] = qnext[ks];
        }
        if (nxt.ok) { ATT_PREFETCH(nxt); if (nxt.it != cur.it) ATT_QPREFETCH(nxt); }
        if (first) {
#pragma unroll
            for (int j = 0; j < 4; ++j) { mrow[j] = -1e30f; lrow[j] = 0.f; }
#pragma unroll
            for (int dt = 0; dt < 8; ++dt) o[dt] = zero4();
        }
        const int dsgn = last ? 1 : -1;
        f32x4 s[8];
#pragma unroll
        for (int kt = 0; kt < 8; ++kt) s[kt] = zero4();
#pragma unroll
        for (int ks = 0; ks < 4; ++ks) { bf16x8 kf[8];
#pragma unroll
            for (int kt = 0; kt < 8; ++kt) kf[kt] = frag_ld(KT, 136, 16 * kt, 32 * ks, lane);
            __builtin_amdgcn_sched_barrier(0);
#pragma unroll
            for (int kt = 0; kt < 8; ++kt) s[kt] = __builtin_amdgcn_mfma_f32_16x16x32_bf16(qf[ks], kf[kt], s[kt], 0, 0, 0); }
        float alpha[4];
#pragma unroll
        for (int j = 0; j < 4; ++j) { const int uq = 16 * w + (lane >> 4) * 4 + j; float mx = -1e30f;
#pragma unroll
            for (int kt = 0; kt < 8; ++kt) { const int uk = 16 * kt + (lane & 15); const int df = (uq - uk) * dsgn; const unsigned mk = (unsigned)(df >> 31);
                const float v = __uint_as_float((__float_as_uint(s[kt][j]) & ~mk) | (0xF149F2CAu & mk)); s[kt][j] = v; mx = fmaxf(mx, v); }
            mx = fmaxf(mx, SHX(mx, 1)); mx = fmaxf(mx, SHX(mx, 2)); mx = fmaxf(mx, SHX(mx, 4)); mx = fmaxf(mx, SHX(mx, 8));
            const float mn = fmaxf(mrow[j], mx); alpha[j] = __expf(mrow[j] - mn); mrow[j] = mn; float rs = 0.f;
#pragma unroll
            for (int kt = 0; kt < 8; ++kt) { const float pv = __expf(s[kt][j] - mn); s[kt][j] = pv; rs += pv; }
            rs += SHX(rs, 1); rs += SHX(rs, 2); rs += SHX(rs, 4); rs += SHX(rs, 8);
            lrow[j] = lrow[j] * alpha[j] + rs; }
#pragma unroll
        for (int dt = 0; dt < 8; ++dt)
#pragma unroll
            for (int j = 0; j < 4; ++j) o[dt][j] *= alpha[j];
#pragma unroll
        for (int kt = 0; kt < 8; ++kt)
#pragma unroll
            for (int j = 0; j < 4; ++j) PW[((lane >> 4) * 4 + j) * 136 + 16 * kt + (lane & 15)] = f2bf(s[kt][j]);
        __builtin_amdgcn_wave_barrier();
#pragma unroll
        for (int ks = 0; ks < 4; ++ks) { const bf16x8 pf = frag_ld(PW, 136, 0, 32 * ks, lane); bf16x8 vf[8];
#pragma unroll
            for (int dt = 0; dt < 8; ++dt) vf[dt] = frag_ld(VT, 136, 16 * dt, 32 * ks, lane);
            __builtin_amdgcn_sched_barrier(0);
#pragma unroll
            for (int dt = 0; dt < 8; ++dt) o[dt] = __builtin_amdgcn_mfma_f32_16x16x32_bf16(pf, vf[dt], o[dt], 0, 0, 0); }
        if (last) {
#pragma unroll
            for (int j = 0; j < 4; ++j) { const float il = 1.f / lrow[j];
#pragma unroll
                for (int dt = 0; dt < 8; ++dt) PW[((lane >> 4) * 4 + j) * 136 + 16 * dt + (lane & 15)] = f2bf(o[dt][j] * il);
                if ((lane & 15) == 0) { const int uq = 128 * cur.qb + 16 * w + (lane >> 4) * 4 + j; LSE[((size_t)cur.g * MP + (size_t)(cur.rowbase + cur.rate * uq)) * 8 + cur.h] = mrow[j] + __logf(lrow[j]); } }
            __builtin_amdgcn_wave_barrier();
#pragma unroll
            for (int i = 0; i < 4; ++i) { const int q = lane + 64 * i, r = q >> 4, ch = q & 15; const size_t row = (size_t)(cur.rowbase + cur.rate * (128 * cur.qb + 16 * w + r));
                *(u32x4*)(OP + ((size_t)cur.g * MP + row) * 1024 + cur.h * 128 + ch * 8) = *(const u32x4*)(PW + r * 136 + ch * 8); }
        }
        __syncthreads();
        cur = nxt;
    }
#undef ATT_PREFETCH
#undef ATT_QPREFETCH
}
__device__ void attn_sample_item(CParams& p, unsigned char* smem, int bs, int h) {
    const int tid = get_tid(), lane = tid & 63, w = __builtin_amdgcn_readfirstlane(tid >> 6);
    float* QS = (float*)smem; float* SC = QS + 384; float* RED = SC + 400; float* PART = RED + 16;
    const bf16_t* QB = (const bf16_t*)(p.ws + B_QB); bf16_t* ATT = (bf16_t*)(p.ws + B_ATT);
    const size_t row = MP + bs;
    if (tid < 384) QS[tid] = bf2f(QB[row * 3072 + ((tid >> 7) * 8 + h) * 128 + (tid & 127)]);
    __syncthreads();
    const int quad = tid & 31, kq = tid >> 5;
    const float* knew = p.out + O_SK + ((size_t)bs * 8 + h) * 128; const float* vnew = p.out + O_SV + ((size_t)bs * 8 + h) * 128;
#pragma unroll 5
    for (int ch = 0; ch < 25; ++ch) { const int pi = ch * 16 + kq; const int pc = pi < 387 ? pi : 386; const int g = pc / 129, j = pc - g * 129; const int rate = g == 0 ? 1 : (g == 1 ? 4 : 16);
        const float* kp = j == 0 ? knew : p.in[4] + (((size_t)bs * 2048 + (2048 - j * rate)) * 8 + h) * 128;
        const f32x4 kv = *(const f32x4*)(kp + 4 * quad), qv = *(const f32x4*)(QS + g * 128 + 4 * quad);
        float d = kv[0] * qv[0] + kv[1] * qv[1] + kv[2] * qv[2] + kv[3] * qv[3];
        d += SHX(d, 16); d += SHX(d, 8); d += SHX(d, 4); d += SHX(d, 2); d += SHX(d, 1);
        if (quad == 0 && pi < 387) SC[pi] = d; }
    __syncthreads();
    float sv = tid < 387 ? SC[tid] : -1e30f; float mx = wave_max(sv, lane); if (lane == 0) RED[w] = mx;
    __syncthreads();
    mx = RED[0];
#pragma unroll
    for (int i = 1; i < 8; ++i) mx = fmaxf(mx, RED[i]);
    const float pv = tid < 387 ? __expf(sv - mx) : 0.f; const float ps = wave_sum(pv, lane);
    __syncthreads();
    if (tid < 387) SC[tid] = pv; if (lane == 0) RED[8 + w] = ps;
    __syncthreads();
    float tot = 0.f;
#pragma unroll
    for (int i = 0; i < 8; ++i) tot += RED[8 + i];
    { f32x4 acc = zero4();
#pragma unroll 5
      for (int ch = 0; ch < 25; ++ch) { const int pi = ch * 16 + kq; const int pc = pi < 387 ? pi : 386; const int g = pc / 129, j = pc - g * 129; const int rate = g == 0 ? 1 : (g == 1 ? 4 : 16);
          const float* vp = j == 0 ? vnew : p.in[5] + (((size_t)bs * 2048 + (2048 - j * rate)) * 8 + h) * 128;
          const f32x4 vv = *(const f32x4*)(vp + 4 * quad); const float pw = pi < 387 ? SC[pc] : 0.f; acc = acc + vv * pw; }
      *(f32x4*)(PART + kq * 128 + 4 * quad) = acc; }
    __syncthreads();
    if (tid < 128) { float o = 0.f;
#pragma unroll
        for (int k = 0; k < 16; ++k) o += PART[k * 128 + tid];
        ATT[row * 1024 + h * 128 + tid] = f2bf(o / tot); }
    __syncthreads();
}
__device__ void phase_attn(CParams& p, unsigned char* smem) {
    attn_prompt(p, smem);
    for (int it = get_bid(); it < 64; it += gridDim.x) attn_sample_item(p, smem, it >> 3, it & 7);
}
__device__ void phase_combine(CParams& p) {
    const bf16_t* OP = (const bf16_t*)(p.ws + B_OP); const float* LSE = (const float*)(p.ws + B_LSE); bf16_t* ATT = (bf16_t*)(p.ws + B_ATT);
    const int stride = gridDim.x * NTHR;
    for (int i0 = get_bid() * NTHR + get_tid(); i0 < MP * 128; i0 += 4 * stride) {
        float l[4][3]; u32x4 v[4][3]; bool ok[4];
#pragma unroll
        for (int k = 0; k < 4; ++k) { const int i = i0 + k * stride; ok[k] = i < MP * 128; const int ii = ok[k] ? i : i0; const int row = ii >> 7, c8 = (ii & 127) * 8, h = c8 >> 7;
#pragma unroll
            for (int g = 0; g < 3; ++g) { l[k][g] = LSE[((size_t)g * MP + row) * 8 + h]; v[k][g] = *(const u32x4*)(OP + ((size_t)g * MP + row) * 1024 + c8); } }
#pragma unroll
        for (int k = 0; k < 4; ++k) { const int i = i0 + k * stride; if (!ok[k]) continue; const int row = i >> 7, c8 = (i & 127) * 8;
            const float mx = fmaxf(l[k][0], fmaxf(l[k][1], l[k][2])); float w0 = __expf(l[k][0] - mx), w1 = __expf(l[k][1] - mx), w2 = __expf(l[k][2] - mx); const float inv = __builtin_amdgcn_rcpf(w0 + w1 + w2); w0 *= inv; w1 *= inv; w2 *= inv;
            u32x4 o;
#pragma unroll
            for (int e = 0; e < 4; ++e) o[e] = pk2(w0 * bf2f(v[k][0][e] & 0xffffu) + w1 * bf2f(v[k][1][e] & 0xffffu) + w2 * bf2f(v[k][2][e] & 0xffffu), w0 * bf2f(v[k][0][e] >> 16) + w1 * bf2f(v[k][1][e] >> 16) + w2 * bf2f(v[k][2][e] >> 16));
            *(u32x4*)(ATT + (size_t)row * 1024 + c8) = o; }
    }
}

#ifndef PROGRAM
#define PROGRAM 0,1,2,3,4,5,6,7,8,9,10,11,12,13,14,15,16,17,18
#endif
__constant__ const int PROG[] = {PROGRAM};
constexpr int NPHASE = sizeof(PROG) / sizeof(int);
#ifndef PHMASK
#define PHMASK 0xFFFFFFFFu
#endif
#define PHON(x) ((PHMASK >> (x)) & 1u)
__global__ __launch_bounds__(512, 2) void yoco_fwd(Params p_unused, int ph_lo, int ph_hi) {
    extern __shared__ __attribute__((aligned(16))) unsigned char smem[];
    volatile LAS unsigned* xst = (volatile LAS unsigned*)(smem + 131072);
    if (threadIdx.x == 0) { xst[0] = 0u; xst[1] = 0u; }
    __syncthreads();
    XcdBarrier xb = xcd_barrier_post((unsigned*)(((CParams*)__builtin_amdgcn_kernarg_segment_ptr())->ws + B_BAR), xst);
    for (int pi = ph_lo; pi < ph_hi; ++pi) {
        const int ph = PROG[pi];
        CParams* pp = (CParams*)__builtin_amdgcn_kernarg_segment_ptr(); asm volatile("" : "+s"(pp));
        CParams& p = *pp; unsigned char* ws = p.ws;
        const bf16_t* XN = (const bf16_t*)(ws + B_XN); const bf16_t* ZX = (const bf16_t*)(ws + B_ZX); const bf16_t* H = (const bf16_t*)(ws + B_H);
        int gk = -1, lda = DM, N = 2048, K = 2048; const bf16_t* A = XN; size_t wo = 0;
        switch (ph) {
#if PHON(0)
        case 0: phase_convert(p, smem); phase_rmsnorm<0>(p); break;
#endif
        case 1: gk = 0; wo = W_IN; N = INP_PAD; break;
#if PHON(2)
        case 2: phase_ssd_states(p, smem); break;
#endif
#if PHON(3)
        case 3: phase_scan(p); break;
#endif
#if PHON(4)
        case 4: phase_ssd_out(p, smem); break;
#endif
#if PHON(5)
        case 5: phase_gnorm(p); break;
#endif
        case 6: gk = 1; A = ZX; lda = ZLD; wo = W_OUT; K = 4096; break;
#if PHON(7)
        case 7: case 10: case 15: phase_rmsnorm<1>(p); break;
#endif
        case 8: gk = 2; wo = W_GU0; N = 11264; break;
        case 9: gk = 1; A = H; lda = FF; wo = W_DN0; K = FF; break;
        case 11: gk = 3; wo = W_KVQ; N = 5120; break;
#if PHON(12)
        case 12: phase_attn(p, smem); break;
#endif
#if PHON(13)
        case 13: phase_combine(p); break;
#endif
        case 14: gk = 1; A = (const bf16_t*)(ws + B_ATT); lda = 1024; wo = W_O; K = 1024; break;
        case 16: gk = 2; wo = W_GU1; N = 11264; break;
        case 17: gk = 1; A = H; lda = FF; wo = W_DN1; K = FF; break;
#if PHON(18)
        case 18: phase_rmsnorm<2>(p); break;
#endif
        default: break;
        }
#if PHON(1)
        if (gk >= 0) { const bool first_res = (ph == 6); const float* XRc = (const float*)(ws + B_XR);
            EpiAll E{gk, ws, p.out, first_res ? p.in[0] : XRc}; run_gemm(smem, A, lda, (const bf16_t*)(ws + wo), N, K, E);
            thin_gemm(p, smem, A, lda, (const bf16_t*)(ws + wo), N, K, gk, first_res ? p.in[1] : XRc + (size_t)MP * 2048);
 }
        {
            const int bid = get_bid(); const bool g256 = gridDim.x == 256; int t0 = -1, ts = 1, te = 0;
            if (ph == 0) { t0 = bid; ts = gridDim.x; te = g256 ? 3936 : 6816; }
            else if (ph == 1 && g256 && bid >= 32) { t0 = 3936 + (bid - 32); ts = 224; te = 5280; }
            else if (ph == 8 && g256 && bid >= 128) { t0 = 5280 + (bid - 128); ts = 128; te = 6048; }
            else if (ph == 11 && g256 && bid >= 128) { t0 = 6048 + (bid - 128); ts = 128; te = 6816; }
            if (t0 >= 0) convert_tiles(p, smem, t0, ts, te); }
#endif
        if (pi + 1 < ph_hi) { if (pi == ph_lo) { __syncthreads(); cg::this_grid().sync(); } else xcd_barrier(xb); }
    }
}

#ifndef MULTI_LAUNCH
#define MULTI_LAUNCH 0
#endif
extern "C" void kernel_launch(void* const* d_in, const int* in_sizes, int n_in, void* d_out, int out_size, void* d_ws, size_t ws_size, hipStream_t stream) {
    static int grid = 0;
    if (grid == 0) {
        if (ws_size < WS_NEED) { fprintf(stderr, "kernel_launch: workspace too small: %zu < %zu\n", ws_size, (size_t)WS_NEED); grid = -1; return; }
        if (hipFuncSetAttribute((const void*)yoco_fwd, hipFuncAttributeMaxDynamicSharedMemorySize, LDS_BYTES) != hipSuccess) { fprintf(stderr, "kernel_launch: hipFuncSetAttribute failed\n"); grid = -1; return; }
        int dev = 0, cus = 0, per_cu = 0;
        (void)hipGetDevice(&dev); (void)hipDeviceGetAttribute(&cus, hipDeviceAttributeMultiprocessorCount, dev);
        (void)hipOccupancyMaxActiveBlocksPerMultiprocessor(&per_cu, (const void*)yoco_fwd, NTHR, LDS_BYTES);
        if (per_cu < 1) { fprintf(stderr, "kernel_launch: occupancy query says %d blocks per CU\n", per_cu); per_cu = 1; }
        grid = cus;
        (void)hipGetLastError();
    }
    if (grid < 0) return;
    if (hipMemsetAsync((unsigned char*)d_ws + B_BAR, 0, 3456 * 4, stream) != hipSuccess) { fprintf(stderr, "kernel_launch: memset of barrier words failed\n"); return; }
    Params p{};
    for (int i = 0; i < 24; ++i) p.in[i] = (const float*)d_in[i];
    p.out = (float*)d_out; p.ws = (unsigned char*)d_ws;
#if MULTI_LAUNCH
    for (int ph = 0; ph < NPHASE; ++ph) hipLaunchKernelGGL(yoco_fwd, dim3(grid), dim3(NTHR), LDS_BYTES, stream, p, ph, ph + 1);
#else
    int lo = 0, hi = NPHASE; void* args[] = {&p, &lo, &hi};
    hipError_t e = hipLaunchCooperativeKernel((const void*)yoco_fwd, dim3(grid), dim3(NTHR), args, LDS_BYTES, stream);
    if (e != hipSuccess) fprintf(stderr, "cooperative launch failed: %s (grid %d)\n", hipGetErrorString(e), grid);
#endif
}
```
